# Optimizing an MI355X kernel written in HIP

```python
import math
import jax, jax.numpy as jnp
from jax import lax
import numpy as np

D_MODEL = 1024
BATCH = 2
SEQ = 8192
DEPTH = 4

HA = 8
DA = 64
HI = 8
DI = 64
TOPK_MAX = 256
HB = 4
DB = 64
CONV_W = 31
D_FF = 2816
NUM_BUCKETS = 32
MAX_DISTANCE = 128
QBLK = 128
ALPHA = (2 * DEPTH) ** 0.25
BETA = (8 * DEPTH) ** -0.25
LN_EPS = 1e-5
SPLITS = (HA * DA, HA * DA, HA * DA, HI * DI, DI, HI, HB * 2 * DB, HB * 2 * DB, HB * 2 * DB)
P_MIX = sum(SPLITS)

kernel_name = "hybrid_dsa_diffattn_conformer_macaron_deepnorm"


def layer_norm(x, g, b):
    xf = x.astype(jnp.float32)
    mu = jnp.mean(xf, axis=-1, keepdims=True)
    var = jnp.mean(jnp.square(xf - mu), axis=-1, keepdims=True)
    y = (xf - mu) * lax.rsqrt(var + LN_EPS)
    return (y * g.astype(jnp.float32) + b.astype(jnp.float32)).astype(x.dtype)


def rms_norm(x, g):
    xf = x.astype(jnp.float32)
    y = xf * lax.rsqrt(jnp.mean(jnp.square(xf), axis=-1, keepdims=True) + LN_EPS)
    return (y * g.astype(jnp.float32)).astype(x.dtype)


def swiglu_ffn(x, w_in, w_out):
    a, u = jnp.split(x @ w_in, 2, axis=-1)
    return (jax.nn.silu(a) * u) @ w_out


def t5_bucket(n):
    n = jnp.maximum(n, 0)
    max_exact = NUM_BUCKETS // 2
    nf = jnp.maximum(n, 1).astype(jnp.float32)
    large = max_exact + (jnp.log(nf / max_exact) / math.log(MAX_DISTANCE / max_exact)
                         * (NUM_BUCKETS - max_exact)).astype(jnp.int32)
    large = jnp.minimum(large, NUM_BUCKETS - 1)
    return jnp.where(n < max_exact, n, large)


def dsa_attention(q, k, v, iq, ik, iw, rel_bias):
    B, S = q.shape[0], q.shape[1]
    top_k = min(TOPK_MAX, S // 4)
    n_blocks = S // QBLK
    key_pos = jnp.arange(S)

    def block(i):
        t0 = i * QBLK
        qb = lax.dynamic_slice_in_dim(q, t0, QBLK, axis=1)
        iqb = lax.dynamic_slice_in_dim(iq, t0, QBLK, axis=1)
        iwb = lax.dynamic_slice_in_dim(iw, t0, QBLK, axis=1)
        qpos = t0 + jnp.arange(QBLK)
        causal = key_pos[None, :] <= qpos[:, None]
        idx_logits = jnp.einsum('bqhd,bsd->bqhs', iqb, ik) * (DI ** -0.5)
        score = jnp.einsum('bqh,bqhs->bqs', iwb, jax.nn.relu(idx_logits))
        score = jnp.where(causal[None], score.astype(jnp.float32), -jnp.inf)
        _, sel = lax.top_k(score, top_k)
        valid = sel <= qpos[None, :, None]
        k_sel = jax.vmap(lambda kk, ss: kk[ss])(k, sel)
        v_sel = jax.vmap(lambda vv, ss: vv[ss])(v, sel)
        logits = jnp.einsum('bqhd,bqkhd->bhqk', qb, k_sel).astype(jnp.float32) * (DA ** -0.5)
        bias = rel_bias[t5_bucket(qpos[None, :, None] - sel)]
        logits = logits + jnp.transpose(bias, (0, 3, 1, 2)).astype(jnp.float32)
        logits = jnp.where(valid[:, None], logits, -jnp.inf)
        p = jax.nn.softmax(logits, axis=-1).astype(v.dtype)
        return jnp.einsum('bhqk,bqkhd->bqhd', p, v_sel)

    out = lax.map(block, jnp.arange(n_blocks))
    return jnp.transpose(out, (1, 0, 2, 3, 4)).reshape(B, S, HA, DA)


def diff_attention(q, k, v, lam_full, rel_bias):
    B, S = q.shape[0], q.shape[1]
    n_blocks = S // QBLK
    key_pos = jnp.arange(S)

    def block(i):
        t0 = i * QBLK
        qb = lax.dynamic_slice_in_dim(q, t0, QBLK, axis=1)
        qpos = t0 + jnp.arange(QBLK)
        causal = key_pos[None, :] <= qpos[:, None]
        logits = jnp.einsum('bqhmd,bshmd->bhmqs', qb, k).astype(jnp.float32) * (DB ** -0.5)
        bias = rel_bias[t5_bucket(qpos[:, None] - key_pos[None, :])]
        logits = logits + jnp.transpose(bias, (2, 0, 1))[None, :, None].astype(jnp.float32)
        logits = jnp.where(causal[None, None, None], logits, -jnp.inf)
        p = jax.nn.softmax(logits, axis=-1)
        attn = (p[:, :, 0] - lam_full * p[:, :, 1]).astype(v.dtype)
        return jnp.einsum('bhqs,bshe->bqhe', attn, v)

    out = lax.map(block, jnp.arange(n_blocks))
    return jnp.transpose(out, (1, 0, 2, 3, 4)).reshape(B, S, HB, 2 * DB)


def attention_mixer(x, w_in, ik_g, ik_b, lam, subln_g, w_out, rel_bias, layer_idx):
    B, S, _ = x.shape
    h = x @ w_in
    qa, ka, va, iq, ik, iw, qb, kb, vb = jnp.split(h, np.cumsum(SPLITS)[:-1].tolist(), axis=-1)
    ik = layer_norm(ik, ik_g, ik_b)
    iw = iw * (HI ** -0.5)
    o_a = dsa_attention(qa.reshape(B, S, HA, DA), ka.reshape(B, S, HA, DA), va.reshape(B, S, HA, DA),
                        iq.reshape(B, S, HI, DI), ik, iw, rel_bias[:, :HA])
    lam_init = 0.8 - 0.6 * math.exp(-0.3 * layer_idx)
    lamf = lam.astype(jnp.float32)
    lam_full = jnp.exp(jnp.sum(lamf[0] * lamf[1])) - jnp.exp(jnp.sum(lamf[2] * lamf[3])) + lam_init
    o_b = diff_attention(qb.reshape(B, S, HB, 2, DB), kb.reshape(B, S, HB, 2, DB),
                         vb.reshape(B, S, HB, 2 * DB), lam_full, rel_bias[:, HA:])
    o_b = rms_norm(o_b, subln_g) * (1.0 - lam_init)
    o = jnp.concatenate([o_a.reshape(B, S, HA * DA), o_b.reshape(B, S, HB * 2 * DB)], axis=-1)
    return o @ w_out


def conv_module(x, w_in, dw, dw_b, g, b, w_out):
    h = x @ w_in
    a, gate = jnp.split(h, 2, axis=-1)
    h = a * jax.nn.sigmoid(gate)
    h = lax.conv_general_dilated(h, dw[:, None, :].astype(h.dtype), window_strides=(1,),
                                 padding=[(CONV_W - 1, 0)],
                                 dimension_numbers=('NWC', 'WIO', 'NWC'),
                                 feature_group_count=D_MODEL) + dw_b
    h = jax.nn.silu(layer_norm(h, g, b))
    return h @ w_out


def setup_inputs(seed: int = 0) -> dict:
    key = jax.random.key(seed)
    ks = jax.random.split(key, 24)
    n_even = (DEPTH + 1) // 2
    n_odd = DEPTH // 2
    D = D_MODEL
    f32 = jnp.float32
    nrm = lambda k, shape, s: (jax.random.normal(k, shape, f32) * s)
    return {
        "x": nrm(ks[0], (BATCH, SEQ, D), 1.0),
        "ffn_in": nrm(ks[1], (DEPTH, 2, D, 2 * D_FF), D ** -0.5),
        "ffn_out": nrm(ks[2], (DEPTH, 2, D_FF, D), BETA * D_FF ** -0.5),
        "ln_g": 1.0 + nrm(ks[3], (DEPTH, 3, D), 0.02),
        "ln_b": nrm(ks[4], (DEPTH, 3, D), 0.02),
        "rel_bias": nrm(ks[5], (NUM_BUCKETS, HA + HB), 0.5),
        "mix_w_in": nrm(ks[6], (n_even, D, P_MIX), D ** -0.5),
        "idx_k_g": 1.0 + nrm(ks[7], (n_even, DI), 0.02),
        "idx_k_b": nrm(ks[8], (n_even, DI), 0.02),
        "diff_lambda": nrm(ks[9], (n_even, 4, DB), 0.1),
        "diff_subln_g": 1.0 + nrm(ks[10], (n_even, 2 * DB), 0.02),
        "mix_w_out": nrm(ks[11], (n_even, D, D), BETA * D ** -0.5),
        "conv_w_in": nrm(ks[12], (n_odd, D, 2 * D), D ** -0.5),
        "conv_dw": nrm(ks[13], (n_odd, CONV_W, D), CONV_W ** -0.5),
        "conv_dw_b": nrm(ks[14], (n_odd, D), 0.02),
        "conv_ln_g": 1.0 + nrm(ks[15], (n_odd, D), 0.02),
        "conv_ln_b": nrm(ks[16], (n_odd, D), 0.02),
        "conv_w_out": nrm(ks[17], (n_odd, D, D), BETA * D ** -0.5),
    }


def reference(x, ffn_in, ffn_out, ln_g, ln_b, rel_bias, mix_w_in, idx_k_g, idx_k_b,
              diff_lambda, diff_subln_g, mix_w_out, conv_w_in, conv_dw, conv_dw_b,
              conv_ln_g, conv_ln_b, conv_w_out):
    for l in range(DEPTH):
        j = l // 2
        x = layer_norm(ALPHA * x + 0.5 * swiglu_ffn(x, ffn_in[l, 0], ffn_out[l, 0]), ln_g[l, 0], ln_b[l, 0])
        if l % 2 == 0:
            m = attention_mixer(x, mix_w_in[j], idx_k_g[j], idx_k_b[j], diff_lambda[j],
                                diff_subln_g[j], mix_w_out[j], rel_bias, l)
        else:
            m = conv_module(x, conv_w_in[j], conv_dw[j], conv_dw_b[j], conv_ln_g[j],
                            conv_ln_b[j], conv_w_out[j])
        x = layer_norm(ALPHA * x + m, ln_g[l, 1], ln_b[l, 1])
        x = layer_norm(ALPHA * x + 0.5 * swiglu_ffn(x, ffn_in[l, 1], ffn_out[l, 1]), ln_g[l, 2], ln_b[l, 2])
    return x
```

```cpp
#include <hip/hip_runtime.h>
#include <hip/hip_cooperative_groups.h>
#include <cstdio>
#include <cstdint>
#include <cmath>
namespace cg = cooperative_groups;
namespace pg8 {
#define PG8_LAS __attribute__((address_space(3)))
typedef unsigned short bf16_t;
typedef short bf16x8 __attribute__((ext_vector_type(8)));
typedef float f32x4 __attribute__((ext_vector_type(4)));
typedef unsigned u32x4 __attribute__((ext_vector_type(4)));
constexpr int BM = 256, BK = 64, HALF = 128, HTB = HALF * BK * 2  , STAGE_BYTES = 8 * HTB, NXCD = 8, WGM = 8;

__host__ __device__ __forceinline__ int lds_byte(int r, int c) { const int st = (r >> 4) * 2 + (c >> 5), rr = r & 15, cc = c & 31, ob = rr * 64 + cc * 2; return st * 1024 + (ob ^ (((ob >> 9) & 1) << 5)); }
__host__ __device__ __forceinline__ void stage_rc(int b, int& R, int& C) { const int st = b / 1024, sb = b % 1024, swz = sb ^ (((sb >> 9) & 1) << 5); R = (st >> 1) * 16 + swz / 64; C = (st & 1) * 32 + (swz % 64) / 2; }
__host__ __device__ __forceinline__ int perm32(int rho) { const int n = rho >> 4, i = rho & 15; return 8 * (i >> 2) + 4 * n + (i & 3); }

struct Unit { int pm, pn; };
struct Gemm { const bf16_t* A; const bf16_t* Bt; int M, N, K; };

struct StaticOrder {
    int nM, nN, nwg, G, c;
    __host__ __device__ void init(int M, int N, int G_, int c_) { nM = M / BM; nN = N / BM; nwg = nM * nN; G = G_; c = c_; }
    __host__ __device__ bool next(int i, Unit& u) const {
        const long L = (long)i * G + c; if (L >= nwg) return false;
        int wgid = (int)L; { const int q = nwg / NXCD, r = nwg % NXCD, xcd = wgid % NXCD, off = wgid / NXCD; wgid = (xcd < r ? xcd * (q + 1) : r * (q + 1) + (xcd - r) * q) + off; }
        const int nig = WGM * nN, gid = wgid / nig, fm = gid * WGM, gsz = (nM - fm) < WGM ? (nM - fm) : WGM;
        u.pm = fm + ((wgid % nig) % gsz); u.pn = (wgid % nig) / gsz; return true;
    }
    __device__ __forceinline__ void a_ready(const Unit&) const {}
    __device__ __forceinline__ void done(const Unit&) const {}
};

__device__ __forceinline__ unsigned cvt_pk_bf16(float lo, float hi) { unsigned r; asm volatile("v_cvt_pk_bf16_f32 %0, %1, %2" : "=v"(r) : "v"(lo), "v"(hi)); return r; }
typedef float f32x2 __attribute__((ext_vector_type(2)));
typedef unsigned u32x4 __attribute__((ext_vector_type(4)));
__device__ __forceinline__ float sigmoidf_fast(float x) { return __builtin_amdgcn_rcpf(1.0f + __builtin_amdgcn_exp2f(-1.4426950408889634f * x)); }
struct EpiBf16 {
    static constexpr bool PERM = true, AFTER_DRAIN = false;
    bf16_t* O; int ldc;
    __device__ __forceinline__ void operator()(const f32x4 (&acc)[2][2][4][2], const Unit& u, int wr, int wc, int fr, int fq) const {
        const int row0 = u.pm * BM + wr * 64 + fr; const int col0 = u.pn * BM + wc * 32 + 8 * fq;
#pragma unroll
        for (int ai = 0; ai < 2; ++ai)
#pragma unroll
            for (int m = 0; m < 4; ++m) { bf16_t* rowp = O + (size_t)(row0 + ai * HALF + m * 16) * ldc + col0;
#pragma unroll
                for (int bj = 0; bj < 2; ++bj) { const f32x4 v0 = acc[ai][bj][m][0], v1 = acc[ai][bj][m][1];
                    u32x4 w; w.x = cvt_pk_bf16(v0[0], v0[1]); w.y = cvt_pk_bf16(v0[2], v0[3]); w.z = cvt_pk_bf16(v1[0], v1[1]); w.w = cvt_pk_bf16(v1[2], v1[3]);
                    *(u32x4*)(rowp + bj * HALF) = w; } }
    }
};
struct EpiAct {
    static constexpr bool PERM = true, AFTER_DRAIN = false;
    bf16_t* O; int ldc; int mode;
    __device__ __forceinline__ void operator()(const f32x4 (&acc)[2][2][4][2], const Unit& u, int wr, int wc, int fr, int fq) const {
        const int row0 = u.pm * BM + wr * 64 + fr; const int col0 = u.pn * HALF + wc * 32 + 8 * fq;
#pragma unroll
        for (int ai = 0; ai < 2; ++ai)
#pragma unroll
            for (int m = 0; m < 4; ++m) { bf16_t* rowp = O + (size_t)(row0 + ai * HALF + m * 16) * ldc + col0;
                float r[8];
#pragma unroll
                for (int n = 0; n < 2; ++n)
#pragma unroll
                    for (int e = 0; e < 4; ++e) { const float a = acc[ai][0][m][n][e], b = acc[ai][1][m][n][e];
                        const float s = sigmoidf_fast(mode ? b : a); r[4 * n + e] = mode ? a * s : a * s * b; }
                u32x4 w; w.x = cvt_pk_bf16(r[0], r[1]); w.y = cvt_pk_bf16(r[2], r[3]); w.z = cvt_pk_bf16(r[4], r[5]); w.w = cvt_pk_bf16(r[6], r[7]);
                *(u32x4*)rowp = w; }
    }
};
struct EpiRes {
    static constexpr bool PERM = false, AFTER_DRAIN = false;
    const float* base; float* out; int ldc; float alpha, scale;
    __device__ __forceinline__ void operator()(const f32x4 (&acc)[2][2][4][2], const Unit& u, int wr, int wc, int fr, int fq) const {
        const int col0 = u.pn * BM + wc * 32 + 4 * fq;
#pragma unroll
        for (int ai = 0; ai < 2; ++ai)
#pragma unroll
            for (int m = 0; m < 4; ++m) { const int r = u.pm * BM + ai * HALF + wr * 64 + m * 16 + fr; const size_t off = (size_t)r * ldc + col0;
#pragma unroll
                for (int bj = 0; bj < 2; ++bj)
#pragma unroll
                    for (int n = 0; n < 2; ++n) { const f32x4 bs = *(const f32x4*)(base + off + bj * HALF + n * 16);
                        *(f32x4*)(out + off + bj * HALF + n * 16) = bs * alpha + acc[ai][bj][m][n] * scale; } }
    }
};
template <class Epi, class Sched, bool ALIGN_EPI = false, bool SP2 = false>
__device__ __forceinline__ void gemm_phase(PG8_LAS unsigned char* lds, const Gemm g, const Sched& S, const Epi& E) {
    int tid_ = threadIdx.x; asm volatile("" : "+v"(tid_));
    const int tid = tid_, wid = __builtin_amdgcn_readfirstlane(tid >> 6), lane = tid & 63, wr = wid >> 2, wc = wid & 3, fr = lane & 15, fq = lane >> 4;
    const int K = g.K, nt = K / BK;
    unsigned voffA[2], voffB[2];
#pragma unroll
    for (int i = 0; i < 2; ++i) { int R, C; stage_rc(tid * 16 + i * 8192, R, C); const int Rb = Epi::PERM ? ((R & ~31) + perm32(R & 31)) : R;
        voffA[i] = (unsigned)(R * K + C) * 2u; voffB[i] = (unsigned)(Rb * K + C) * 2u; }
    const size_t kstep = (size_t)(BK * 2);
    const size_t hstep = (size_t)HALF * K * 2;
    const size_t tstep = 2 * hstep;
    const unsigned ldsw = (unsigned)wid * 1024u;
    const int aoff = lds_byte(wr * 64 + fr, fq * 8), boff = lds_byte(wc * 32 + fr, fq * 8);
#define PG8_SA(b, h) (((b) * 2 + (h)) * HTB)
#define PG8_SB(b, h) ((4 + (b) * 2 + (h)) * HTB)
#define PG8_STAGE(bufoff, gbase, voff) do { _Pragma("unroll") for (int _i = 0; _i < 2; ++_i) \
        __builtin_amdgcn_global_load_lds((const unsigned*)((const char*)(gbase) + (voff)[_i]), (PG8_LAS unsigned*)(lds + (bufoff) + ldsw + _i * 8192), 16, 0, 0); } while (0)
#define PG8_LDA(dst, b, h) do { _Pragma("unroll") for (int m = 0; m < 4; ++m) _Pragma("unroll") for (int k = 0; k < 2; ++k) dst[m][k] = *(const PG8_LAS bf16x8*)(lds + PG8_SA(b, h) + aoff + m * 2048 + k * 1024); } while (0)
#define PG8_LDB(dst, b, h) do { _Pragma("unroll") for (int n = 0; n < 2; ++n) _Pragma("unroll") for (int k = 0; k < 2; ++k) dst[n][k] = *(const PG8_LAS bf16x8*)(lds + PG8_SB(b, h) + boff + n * 2048 + k * 1024); } while (0)
#define PG8_MMA(ai, bj, At, Bt) do { __builtin_amdgcn_s_setprio(1); _Pragma("unroll") for (int m = 0; m < 4; ++m) _Pragma("unroll") for (int n = 0; n < 2; ++n) _Pragma("unroll") for (int k = 0; k < 2; ++k) \
        acc[ai][bj][m][n] = __builtin_amdgcn_mfma_f32_16x16x32_bf16(Bt[n][k], At[m][k], acc[ai][bj][m][n], 0, 0, 0); __builtin_amdgcn_s_setprio(0); } while (0)
#define PG8_WAIT_V(n) asm volatile("s_waitcnt vmcnt(" #n ")" ::: "memory")
#define PG8_WAIT_L(n) asm volatile("s_waitcnt lgkmcnt(" #n ")" ::: "memory")
#define PG8_BAR __builtin_amdgcn_s_barrier()
#define PG8_SCHED __builtin_amdgcn_sched_barrier(0)
    Unit cur, nxt; int ui = 0;
    if (!S.next(0, cur)) return;
    f32x4 acc[2][2][4][2];
#pragma unroll
    for (int a = 0; a < 2; ++a)
#pragma unroll
        for (int b = 0; b < 2; ++b)
#pragma unroll
            for (int m = 0; m < 4; ++m)
#pragma unroll
                for (int n = 0; n < 2; ++n) acc[a][b][m][n] = (f32x4){0.f, 0.f, 0.f, 0.f};
    bf16x8 At[4][2], B0[2][2], B1[2][2];
    const char* cA = (const char*)g.A + (size_t)cur.pm * tstep; const char* cB = (const char*)g.Bt + (size_t)cur.pn * tstep;
    S.a_ready(cur);
    if constexpr (SP2) {
        PG8_STAGE(PG8_SB(0, 0), cB, voffB); PG8_STAGE(PG8_SB(0, 1), cB + hstep, voffB); PG8_STAGE(PG8_SA(0, 0), cA, voffA); PG8_STAGE(PG8_SA(0, 1), cA + hstep, voffA);
        if (wr == 1) PG8_BAR;
        PG8_WAIT_V(2); PG8_BAR;
        PG8_STAGE(PG8_SB(1, 0), cB + kstep, voffB); PG8_STAGE(PG8_SA(1, 0), cA + kstep, voffA); PG8_STAGE(PG8_SB(1, 1), cB + hstep + kstep, voffB);
        PG8_WAIT_V(6); PG8_BAR;
    } else {
        PG8_STAGE(PG8_SB(0, 0), cB, voffB); PG8_STAGE(PG8_SA(0, 0), cA, voffA); PG8_STAGE(PG8_SB(0, 1), cB + hstep, voffB); PG8_STAGE(PG8_SA(0, 1), cA + hstep, voffA);
        if (wr == 1) PG8_BAR;
        PG8_WAIT_V(4); PG8_BAR;
        PG8_STAGE(PG8_SB(1, 0), cB + kstep, voffB); PG8_STAGE(PG8_SA(1, 0), cA + kstep, voffA); PG8_STAGE(PG8_SB(1, 1), cB + hstep + kstep, voffB);
        PG8_WAIT_V(6); PG8_BAR;
    }
    for (;;) {
        const bool has_next = S.next(ui + 1, nxt);
        const char* nA = has_next ? (const char*)g.A + (size_t)nxt.pm * tstep : cA; const char* nB = has_next ? (const char*)g.Bt + (size_t)nxt.pn * tstep : cB;
        for (int t = 0; t < nt; t += 2) {
            const bool last = (t == nt - 2);
            const char* a1 = cA + (size_t)(t + 1) * kstep;
            const char* a2 = last ? nA : cA + (size_t)(t + 2) * kstep; const char* b2 = last ? nB : cB + (size_t)(t + 2) * kstep;
            const char* a3 = a2 + kstep; const char* b3 = b2 + kstep;
            if (last && has_next) S.a_ready(nxt);
            if constexpr (SP2) {
            PG8_LDB(B0, 0, 0); PG8_LDB(B1, 0, 1); PG8_SCHED; PG8_LDA(At, 0, 0); PG8_STAGE(PG8_SA(1, 1), a1 + hstep, voffA);
            PG8_WAIT_V(8); PG8_WAIT_L(0); PG8_BAR; PG8_MMA(0, 0, At, B0); PG8_MMA(0, 1, At, B1); PG8_BAR; PG8_SCHED;
            PG8_LDA(At, 0, 1); PG8_STAGE(PG8_SB(0, 0), b2, voffB); PG8_STAGE(PG8_SB(0, 1), b2 + hstep, voffB); PG8_STAGE(PG8_SA(0, 0), a2, voffA);
            PG8_WAIT_V(8); PG8_WAIT_L(0); PG8_BAR; PG8_MMA(1, 0, At, B0); PG8_MMA(1, 1, At, B1); PG8_BAR; PG8_SCHED;
            PG8_LDB(B0, 1, 0); PG8_LDB(B1, 1, 1); PG8_SCHED; PG8_LDA(At, 1, 0); PG8_STAGE(PG8_SA(0, 1), a2 + hstep, voffA);
            PG8_WAIT_V(8); PG8_WAIT_L(0); PG8_BAR; PG8_MMA(0, 0, At, B0); PG8_MMA(0, 1, At, B1); PG8_BAR; PG8_SCHED;
            PG8_LDA(At, 1, 1); PG8_STAGE(PG8_SB(1, 0), b3, voffB); PG8_STAGE(PG8_SB(1, 1), b3 + hstep, voffB); PG8_STAGE(PG8_SA(1, 0), a3, voffA);
            PG8_WAIT_V(8); PG8_WAIT_L(0); PG8_BAR; PG8_MMA(1, 0, At, B0); PG8_MMA(1, 1, At, B1); PG8_BAR; PG8_SCHED;
            } else {
            PG8_LDB(B0, 0, 0); PG8_SCHED; PG8_LDA(At, 0, 0); PG8_STAGE(PG8_SA(1, 1), a1 + hstep, voffA);
            PG8_WAIT_L(8); PG8_BAR; PG8_WAIT_L(0); PG8_MMA(0, 0, At, B0); PG8_BAR; PG8_SCHED;
            PG8_LDB(B1, 0, 1); PG8_STAGE(PG8_SB(0, 0), b2, voffB);
            PG8_BAR; PG8_WAIT_L(0); PG8_MMA(0, 1, At, B1); PG8_BAR;
            PG8_LDA(At, 0, 1); PG8_STAGE(PG8_SA(0, 0), a2, voffA);
            PG8_BAR; PG8_WAIT_L(0); PG8_MMA(1, 0, At, B0); PG8_BAR; PG8_SCHED;
            PG8_STAGE(PG8_SB(0, 1), b2 + hstep, voffB);
            PG8_WAIT_V(6); PG8_BAR; PG8_MMA(1, 1, At, B1); PG8_BAR;
            PG8_LDB(B0, 1, 0); PG8_SCHED; PG8_LDA(At, 1, 0); PG8_STAGE(PG8_SA(0, 1), a2 + hstep, voffA);
            PG8_WAIT_L(8); PG8_BAR; PG8_WAIT_L(0); PG8_MMA(0, 0, At, B0); PG8_BAR; PG8_SCHED;
            PG8_LDB(B1, 1, 1); PG8_STAGE(PG8_SB(1, 0), b3, voffB);
            PG8_BAR; PG8_WAIT_L(0); PG8_MMA(0, 1, At, B1); PG8_BAR;
            PG8_LDA(At, 1, 1); PG8_STAGE(PG8_SA(1, 0), a3, voffA);
            PG8_BAR; PG8_WAIT_L(0); PG8_MMA(1, 0, At, B0); PG8_BAR; PG8_SCHED;
            PG8_STAGE(PG8_SB(1, 1), b3 + hstep, voffB);
            PG8_WAIT_V(6); PG8_BAR; PG8_MMA(1, 1, At, B1); PG8_BAR;
            }
        }
        if constexpr (ALIGN_EPI) { if (wr == 0) PG8_BAR; }
        if constexpr (!Epi::AFTER_DRAIN) { E(acc, cur, wr, wc, fr, fq); S.done(cur); }
        if (!has_next) break;
#pragma unroll
        for (int a = 0; a < 2; ++a)
#pragma unroll
            for (int b = 0; b < 2; ++b)
#pragma unroll
                for (int m = 0; m < 4; ++m)
#pragma unroll
                    for (int n = 0; n < 2; ++n) acc[a][b][m][n] = (f32x4){0.f, 0.f, 0.f, 0.f};
        cur = nxt; cA = nA; cB = nB; ++ui;
        if constexpr (ALIGN_EPI) { if (wr == 1) PG8_BAR; }
    }
    PG8_WAIT_V(0);
    if constexpr (!ALIGN_EPI) { if (wr == 0) PG8_BAR; }
    PG8_BAR;
    if constexpr (Epi::AFTER_DRAIN) { E.fused(acc, cur, wr, wc, fr, fq, lds, wid, lane); S.done(cur); }
#undef PG8_SA
#undef PG8_SB
#undef PG8_STAGE
#undef PG8_LDA
#undef PG8_LDB
#undef PG8_MMA
#undef PG8_WAIT_V
#undef PG8_WAIT_L
#undef PG8_BAR
#undef PG8_SCHED
}
}
#ifndef EN_MASK
#define EN_MASK 0xffff
#endif
#define EN_PRO ((EN_MASK) & 1)
#define EN_GEMM1 ((EN_MASK) & 2)
#define EN_GEMM2 ((EN_MASK) & 4)
#define EN_GEMM3 ((EN_MASK) & 8)
#define EN_LN ((EN_MASK) & 16)
#define EN_IKLN ((EN_MASK) & 32)
#define EN_CONV ((EN_MASK) & 64)
#define EN_DIFF ((EN_MASK) & 128)
#define EN_DSA ((EN_MASK) & 256)
constexpr int SEQ = 8192, NB = 2, MTOK = NB * SEQ, DM = 1024, DFF = 2816, DEPTH = 4;
constexpr int PW = 3840;
constexpr int COL_QA = 0, COL_KA = 512, COL_VA = 1024, COL_IQ = 1536, COL_QB = 2048, COL_KB = 2560, COL_VB = 3072, COL_IK = 3584, COL_IW = 3648;
constexpr int PMIX = 3656;
constexpr float LN_EPS = 1e-5f;
constexpr float ALPHA = 1.6817928305074290f;
constexpr float LOG2E = 1.4426950408889634f;
constexpr int NTHREADS = 512, NWAVES = 8;
constexpr size_t MiB = 1u << 20;
constexpr size_t WS_WFI = 0, SZ_WFI = 11 * MiB;
constexpr size_t WS_WFO = 88 * MiB, SZ_WFO = 5632 * 1024;
constexpr size_t WS_WMI = 132 * MiB, SZ_WMI = (size_t)PW * 1024 * 2;
constexpr size_t WS_WMO = 147 * MiB, SZ_WMO = 2 * MiB;
constexpr size_t WS_WCI = 151 * MiB, SZ_WCI = 4 * MiB;
constexpr size_t WS_WCO = 159 * MiB, SZ_WCO = 2 * MiB;
constexpr size_t WS_XB = 164 * MiB;
constexpr size_t WS_PB = 196 * MiB;
constexpr size_t WS_Y = 316 * MiB;
constexpr size_t WS_SCR = 380 * MiB;
constexpr size_t WS_IK = 508 * MiB;
constexpr size_t WS_END = 510 * MiB;
constexpr int LDS_BYTES = 131072 + 8192;
constexpr int LDS_LUT = 131072;

typedef unsigned short bf16;
typedef short bf16x8 __attribute__((ext_vector_type(8)));
typedef short s16x4 __attribute__((ext_vector_type(4)));
typedef float f32x4 __attribute__((ext_vector_type(4)));
typedef float f32x16 __attribute__((ext_vector_type(16)));
typedef unsigned u32x4 __attribute__((ext_vector_type(4)));
typedef unsigned u32x2 __attribute__((ext_vector_type(2)));
#define LAS __attribute__((address_space(3)))

__device__ __forceinline__ unsigned f2bf(float f) { unsigned u = __builtin_bit_cast(unsigned, f); return (u + 0x7fffu + ((u >> 16) & 1u)) >> 16; }
__device__ __forceinline__ unsigned pk2(float lo, float hi) { return f2bf(lo) | (f2bf(hi) << 16); }
__device__ __forceinline__ float bflo(unsigned w) { return __builtin_bit_cast(float, w << 16); }
__device__ __forceinline__ float bfhi(unsigned w) { return __builtin_bit_cast(float, w & 0xffff0000u); }
__device__ __forceinline__ float wave_sum(float v) {
#pragma unroll
    for (int o = 1; o < 64; o <<= 1) v += __shfl_xor(v, o);
    return v;
}
__device__ __forceinline__ int launder_tid() { int t = threadIdx.x; asm volatile("" : "+v"(t)); return t; }
__device__ __forceinline__ int wave_sum_i(int v) {
#pragma unroll
    for (int o = 1; o < 64; o <<= 1) v += __shfl_xor(v, o);
    return v;
}
__device__ __forceinline__ int crow(int r, int hi) { return (r & 3) + 8 * (r >> 2) + 4 * hi; }

struct Params { const float* in[18]; float* out; unsigned char* ws; int ph_lo, ph_hi; };

__device__ __forceinline__ int dest_row(int n, int mode, int NH) {
    if (mode == 0) return n;
    if (mode == 1) { const int hf = n >= NH ? 1 : 0, nn = n - hf * NH; return (nn >> 7) * 256 + hf * 128 + (nn & 127); }
    if (n < 2048) return n;
    if (n < 2112) return COL_IK + (n - 2048);
    if (n < 2120) return COL_IW + (n - 2112);
    return COL_QB + (n - 2120);
}
__device__ __forceinline__ void transpose_item(const float* W, int K, int N, bf16* WT, int mode, LAS float* scr, int item, int lane) {
    const int nblk = (N + 31) / 32, kb = item / nblk, nb = item % nblk, k0 = 64 * kb, n0 = 32 * nb;
    const int nr = n0 + (lane & 31);
#pragma unroll 8
    for (int i = 0; i < 32; ++i) { const int kk = 2 * i + (lane >> 5); scr[kk * 33 + (lane & 31)] = nr < N ? W[(size_t)(k0 + kk) * N + nr] : 0.f; }
    asm volatile("s_waitcnt lgkmcnt(0)" ::: "memory");
    const int c = lane & 7;
#pragma unroll
    for (int j = 0; j < 4; ++j) { const int n = (lane >> 3) + 8 * j; const LAS float* s = scr + (8 * c) * 33 + n;
        u32x4 o; o.x = pk2(s[0 * 33], s[1 * 33]); o.y = pk2(s[2 * 33], s[3 * 33]); o.z = pk2(s[4 * 33], s[5 * 33]); o.w = pk2(s[6 * 33], s[7 * 33]);
        if (n0 + n < N) *(u32x4*)(WT + (size_t)dest_row(n0 + n, mode, N / 2) * K + k0 + 8 * c) = o; }
    asm volatile("s_waitcnt lgkmcnt(0)" ::: "memory");
}
__device__ __forceinline__ void prologue_phase(const Params& p, unsigned char* lds) {
    const int tid = launder_tid(), lane = tid & 63, wave = __builtin_amdgcn_readfirstlane(tid >> 6);
    LAS float* scr = (LAS float*)((LAS unsigned char*)lds + wave * 16384);
    const int gw = blockIdx.x * NWAVES + wave, NGW = gridDim.x * NWAVES;
    unsigned char* ws = p.ws;
    constexpr int I_FI = (1024 / 64) * (5632 / 32), I_FO = (2816 / 64) * (1024 / 32), I_MI = (1024 / 64) * ((PMIX + 31) / 32), I_SQ = (1024 / 64) * (1024 / 32), I_CI = (1024 / 64) * (2048 / 32);
    constexpr int T_FI = 8 * I_FI, T_FO = 8 * I_FO, T_MI = 2 * I_MI, T_MO = 2 * I_SQ, T_CI = 2 * I_CI, T_CO = 2 * I_SQ;
    constexpr int NITEMS = T_FI + T_FO + T_MI + T_MO + T_CI + T_CO;
    for (int it = gw; it < NITEMS; it += NGW) {
        int r = it;
        if (r < T_FI) { const int w = r / I_FI; transpose_item(p.in[1] + (size_t)w * 1024 * 5632, 1024, 5632, (bf16*)(ws + WS_WFI + w * SZ_WFI), 1, scr, r % I_FI, lane); continue; } r -= T_FI;
        if (r < T_FO) { const int w = r / I_FO; transpose_item(p.in[2] + (size_t)w * 2816 * 1024, 2816, 1024, (bf16*)(ws + WS_WFO + w * SZ_WFO), 0, scr, r % I_FO, lane); continue; } r -= T_FO;
        if (r < T_MI) { const int w = r / I_MI; transpose_item(p.in[6] + (size_t)w * 1024 * PMIX, 1024, PMIX, (bf16*)(ws + WS_WMI + w * SZ_WMI), 2, scr, r % I_MI, lane); continue; } r -= T_MI;
        if (r < T_MO) { const int w = r / I_SQ; transpose_item(p.in[11] + (size_t)w * 1024 * 1024, 1024, 1024, (bf16*)(ws + WS_WMO + w * SZ_WMO), 0, scr, r % I_SQ, lane); continue; } r -= T_MO;
        if (r < T_CI) { const int w = r / I_CI; transpose_item(p.in[12] + (size_t)w * 1024 * 2048, 1024, 2048, (bf16*)(ws + WS_WCI + w * SZ_WCI), 1, scr, r % I_CI, lane); continue; } r -= T_CI;
        { const int w = r / I_SQ; transpose_item(p.in[17] + (size_t)w * 1024 * 1024, 1024, 1024, (bf16*)(ws + WS_WCO + w * SZ_WCO), 0, scr, r % I_SQ, lane); }
    }
    const float* x = p.in[0]; bf16* xb = (bf16*)(ws + WS_XB);
    for (int m = gw; m < MTOK; m += NGW) {
        const f32x4* xr = (const f32x4*)(x + (size_t)m * DM) + lane; u32x2* o = (u32x2*)(xb + (size_t)m * DM) + lane;
#pragma unroll
        for (int j = 0; j < 4; ++j) { const f32x4 v = xr[64 * j]; u32x2 w; w.x = pk2(v.x, v.y); w.y = pk2(v.z, v.w); o[64 * j] = w; }
    }
}
__device__ __forceinline__ void ln_phase(const float* Y, const float* g, const float* bta, float* X, bf16* XB) {
    const int tid = launder_tid(), lane = tid & 63, wave = __builtin_amdgcn_readfirstlane(tid >> 6);
    const int gw = blockIdx.x * NWAVES + wave, NGW = gridDim.x * NWAVES;
    f32x4 gv[4], bv[4];
#pragma unroll
    for (int j = 0; j < 4; ++j) { gv[j] = ((const f32x4*)g)[lane + 64 * j]; bv[j] = ((const f32x4*)bta)[lane + 64 * j]; }
    for (int m = gw; m < MTOK; m += NGW) {
        const f32x4* yr = (const f32x4*)(Y + (size_t)m * DM) + lane;
        f32x4 v[4]; float s = 0.f;
#pragma unroll
        for (int j = 0; j < 4; ++j) { v[j] = yr[64 * j]; s += (v[j].x + v[j].y) + (v[j].z + v[j].w); }
        const float mean = wave_sum(s) * (1.f / DM); float s2 = 0.f;
#pragma unroll
        for (int j = 0; j < 4; ++j) { v[j] = v[j] - mean; s2 += (v[j].x * v[j].x + v[j].y * v[j].y) + (v[j].z * v[j].z + v[j].w * v[j].w); }
        const float rstd = 1.0f / sqrtf(wave_sum(s2) * (1.f / DM) + LN_EPS);
        f32x4* xo = (f32x4*)(X + (size_t)m * DM) + lane; u32x2* bo = (u32x2*)(XB + (size_t)m * DM) + lane;
#pragma unroll
        for (int j = 0; j < 4; ++j) { const f32x4 o = v[j] * rstd * gv[j] + bv[j]; xo[64 * j] = o; u32x2 w; w.x = pk2(o.x, o.y); w.y = pk2(o.z, o.w); bo[64 * j] = w; }
    }
}
__device__ __forceinline__ void ikln_phase(const bf16* P, const float* g, const float* bta, bf16* IK) {
    const int gt = blockIdx.x * NTHREADS + launder_tid(), NT = gridDim.x * NTHREADS;
    for (int m = gt; m < MTOK; m += NT) {
        const u32x4* src = (const u32x4*)(P + (size_t)m * PW + COL_IK);
        float v[64]; float s = 0.f;
#pragma unroll
        for (int c = 0; c < 8; ++c) { const u32x4 w = src[c];
            v[8 * c + 0] = bflo(w.x); v[8 * c + 1] = bfhi(w.x); v[8 * c + 2] = bflo(w.y); v[8 * c + 3] = bfhi(w.y);
            v[8 * c + 4] = bflo(w.z); v[8 * c + 5] = bfhi(w.z); v[8 * c + 6] = bflo(w.w); v[8 * c + 7] = bfhi(w.w); }
#pragma unroll
        for (int i = 0; i < 64; ++i) s += v[i];
        const float mean = s * (1.f / 64.f); float s2 = 0.f;
#pragma unroll
        for (int i = 0; i < 64; ++i) { v[i] -= mean; s2 += v[i] * v[i]; }
        const float rstd = 1.0f / sqrtf(s2 * (1.f / 64.f) + LN_EPS);
        u32x4* dst = (u32x4*)(IK + (size_t)m * 64);
#pragma unroll
        for (int c = 0; c < 8; ++c) { u32x4 w;
            w.x = pk2(v[8 * c + 0] * rstd * g[8 * c + 0] + bta[8 * c + 0], v[8 * c + 1] * rstd * g[8 * c + 1] + bta[8 * c + 1]);
            w.y = pk2(v[8 * c + 2] * rstd * g[8 * c + 2] + bta[8 * c + 2], v[8 * c + 3] * rstd * g[8 * c + 3] + bta[8 * c + 3]);
            w.z = pk2(v[8 * c + 4] * rstd * g[8 * c + 4] + bta[8 * c + 4], v[8 * c + 5] * rstd * g[8 * c + 5] + bta[8 * c + 5]);
            w.w = pk2(v[8 * c + 6] * rstd * g[8 * c + 6] + bta[8 * c + 6], v[8 * c + 7] * rstd * g[8 * c + 7] + bta[8 * c + 7]);
            dst[c] = w; }
    }
}
__device__ __forceinline__ void conv_phase(const bf16* U, const float* dw, const float* dwb, const float* g, const float* bta, bf16* V) {
    const int tid = launder_tid(), lane = tid & 63, wave = __builtin_amdgcn_readfirstlane(tid >> 6);
    const int gw = blockIdx.x * NWAVES + wave, NGW = gridDim.x * NWAVES;
    for (int m = gw; m < MTOK; m += NGW) {
        const int t = m & (SEQ - 1);
        float acc[16];
#pragma unroll
        for (int jj = 0; jj < 2; ++jj) { const int c0 = lane * 8 + 512 * jj; const f32x4 b0 = *(const f32x4*)(dwb + c0), b1 = *(const f32x4*)(dwb + c0 + 4);
            acc[8 * jj + 0] = b0.x; acc[8 * jj + 1] = b0.y; acc[8 * jj + 2] = b0.z; acc[8 * jj + 3] = b0.w; acc[8 * jj + 4] = b1.x; acc[8 * jj + 5] = b1.y; acc[8 * jj + 6] = b1.z; acc[8 * jj + 7] = b1.w; }
        const int j0 = t >= 30 ? 0 : 30 - t;
        for (int j = j0; j < 31; ++j) {
            const bf16* urow = U + (size_t)(m - 30 + j) * DM; const float* wrow = dw + (size_t)j * DM;
#pragma unroll
            for (int jj = 0; jj < 2; ++jj) { const int c0 = lane * 8 + 512 * jj; const u32x4 u = *(const u32x4*)(urow + c0); const f32x4 w0 = *(const f32x4*)(wrow + c0), w1 = *(const f32x4*)(wrow + c0 + 4);
                acc[8 * jj + 0] += bflo(u.x) * w0.x; acc[8 * jj + 1] += bfhi(u.x) * w0.y; acc[8 * jj + 2] += bflo(u.y) * w0.z; acc[8 * jj + 3] += bfhi(u.y) * w0.w;
                acc[8 * jj + 4] += bflo(u.z) * w1.x; acc[8 * jj + 5] += bfhi(u.z) * w1.y; acc[8 * jj + 6] += bflo(u.w) * w1.z; acc[8 * jj + 7] += bfhi(u.w) * w1.w; }
        }
        float s = 0.f;
#pragma unroll
        for (int i = 0; i < 16; ++i) s += acc[i];
        const float mean = wave_sum(s) * (1.f / DM); float s2 = 0.f;
#pragma unroll
        for (int i = 0; i < 16; ++i) { acc[i] -= mean; s2 += acc[i] * acc[i]; }
        const float rstd = 1.0f / sqrtf(wave_sum(s2) * (1.f / DM) + LN_EPS);
#pragma unroll
        for (int jj = 0; jj < 2; ++jj) { const int c0 = lane * 8 + 512 * jj; float o[8];
#pragma unroll
            for (int e = 0; e < 8; ++e) { const float y = acc[8 * jj + e] * rstd * g[c0 + e] + bta[c0 + e]; o[e] = y * pg8::sigmoidf_fast(y); }
            u32x4 w; w.x = pk2(o[0], o[1]); w.y = pk2(o[2], o[3]); w.z = pk2(o[4], o[5]); w.w = pk2(o[6], o[7]);
            *(u32x4*)(V + (size_t)m * DM + c0) = w; }
    }
}
__device__ __forceinline__ int t5_bucket(int n) {
    if (n < 16) return n;
    int v = 16 + (int)(logf((float)n / 16.0f) / logf(8.0f) * 16.0f);
    return v < 31 ? v : 31;
}
__device__ __forceinline__ unsigned cvtpk(float lo, float hi) { typedef float f2 __attribute__((ext_vector_type(2))); typedef __bf16 b2 __attribute__((ext_vector_type(2))); f2 v = {lo, hi}; b2 b = __builtin_convertvector(v, b2); return __builtin_bit_cast(unsigned, b); }
__device__ __forceinline__ bf16x8 pack8(const f32x16& x, int s) {
    u32x4 p; p.x = cvtpk(x[8 * s + 0], x[8 * s + 1]); p.y = cvtpk(x[8 * s + 2], x[8 * s + 3]); p.z = cvtpk(x[8 * s + 4], x[8 * s + 5]); p.w = cvtpk(x[8 * s + 6], x[8 * s + 7]);
    return __builtin_bit_cast(bf16x8, p);
}
typedef short v4i16_t __attribute__((ext_vector_type(4)));
__device__ __forceinline__ s16x4 vtr(const LAS unsigned char* p) { return __builtin_bit_cast(s16x4, __builtin_amdgcn_ds_read_tr16_b64_v4i16((LAS v4i16_t*)p)); }

__device__ __forceinline__ void diff_unit(unsigned char* ldsg, const bf16* P, bf16* O, int b, int h, int qb, float lam_full, float oscale, const float* subg) {
    LAS unsigned char* lds = (LAS unsigned char*)ldsg;
    const int tid = launder_tid(), lane = tid & 63, wid = __builtin_amdgcn_readfirstlane(tid >> 6), r32 = lane & 31, hi = lane >> 5;
    const int map = wid >> 2, qs = wid & 3;
    const int q0 = qb * 128, qmin = q0 + qs * 32, myq = qmin + r32;
    const size_t rowbase = (size_t)b * SEQ;
    constexpr int RS = 272, TILE = 64 * RS;
    LAS float* wsf = (LAS float*)(lds + 4 * TILE) + wid * 32;
    const LAS float* lut = (const LAS float*)(lds + LDS_LUT) + (8 + h) * 129;
    bf16x8 qr[4];
    { const bf16* qp = P + (rowbase + myq) * PW + COL_QB + h * 128 + map * 64 + hi * 8;
#pragma unroll
      for (int d0 = 0; d0 < 4; ++d0) qr[d0] = *(const bf16x8*)(qp + d0 * 16); }
    const int NT = 2 * qb + 2;
    f32x16 o[4];
#pragma unroll
    for (int d = 0; d < 4; ++d)
#pragma unroll
        for (int i = 0; i < 16; ++i) o[d][i] = 0.f;
    float mrun = -INFINITY, lrun = 0.f;
    const float SC = 0.125f * LOG2E;
    const int lrow0 = tid >> 4, lc16 = tid & 15;
    const bf16* kg = P + (rowbase + lrow0) * PW + COL_KB + h * 128 + lc16 * 8;
    const bf16* vg = P + (rowbase + lrow0) * PW + COL_VB + h * 128 + lc16 * 8;
    u32x4 kr[2], vr[2];
#pragma unroll
    for (int i = 0; i < 2; ++i) { kr[i] = *(const u32x4*)(kg + (size_t)(32 * i) * PW); vr[i] = *(const u32x4*)(vg + (size_t)(32 * i) * PW); }
    const int q4 = (lane & 15) >> 2;
    const int vcol = (16 * ((lane >> 4) & 1) + 4 * (lane & 3)) * 2;
    for (int t = 0; t < NT; ++t) {
        const int buf = t & 1;
        LAS unsigned char* Kb = lds + buf * TILE; LAS unsigned char* Vb = lds + (2 + buf) * TILE;
#pragma unroll
        for (int i = 0; i < 2; ++i) { *(LAS u32x4*)(Kb + (lrow0 + 32 * i) * RS + lc16 * 16) = kr[i]; *(LAS u32x4*)(Vb + (lrow0 + 32 * i) * RS + lc16 * 16) = vr[i]; }
        __syncthreads();
        if (t + 1 < NT) {
#pragma unroll
            for (int i = 0; i < 2; ++i) { kr[i] = *(const u32x4*)(kg + (size_t)(64 * (t + 1) + 32 * i) * PW); vr[i] = *(const u32x4*)(vg + (size_t)(64 * (t + 1) + 32 * i) * PW); }
        }
        const int kb0 = 64 * t;
        if (kb0 > qmin + 31) continue;
        f32x16 p0, p1;
#pragma unroll
        for (int i = 0; i < 16; ++i) { p0[i] = 0.f; p1[i] = 0.f; }
#pragma unroll
        for (int d0 = 0; d0 < 4; ++d0) {
            const bf16x8 a0 = *(const LAS bf16x8*)(Kb + r32 * RS + (map * 64 + d0 * 16 + hi * 8) * 2);
            const bf16x8 a1 = *(const LAS bf16x8*)(Kb + (32 + r32) * RS + (map * 64 + d0 * 16 + hi * 8) * 2);
            p0 = __builtin_amdgcn_mfma_f32_32x32x16_bf16(a0, qr[d0], p0, 0, 0, 0);
            p1 = __builtin_amdgcn_mfma_f32_32x32x16_bf16(a1, qr[d0], p1, 0, 0, 0);
        }
        if (qmin - (kb0 + 63) >= 128) {
            const float c = lut[128];
#pragma unroll
            for (int i = 0; i < 16; ++i) { p0[i] = p0[i] * SC + c; p1[i] = p1[i] * SC + c; }
        } else {
#pragma unroll
            for (int i = 0; i < 16; ++i) {
                const int n0 = myq - (kb0 + crow(i, hi)), n1 = n0 - 32;
                const float b0 = lut[n0 < 0 ? 0 : (n0 > 128 ? 128 : n0)], b1 = lut[n1 < 0 ? 0 : (n1 > 128 ? 128 : n1)];
                p0[i] = n0 < 0 ? -INFINITY : p0[i] * SC + b0; p1[i] = n1 < 0 ? -INFINITY : p1[i] * SC + b1;
            }
        }
        float rm = fmaxf(p0[0], p1[0]);
#pragma unroll
        for (int i = 1; i < 16; ++i) rm = fmaxf(rm, fmaxf(p0[i], p1[i]));
        rm = fmaxf(rm, __shfl_xor(rm, 32));
        const float mnew = fmaxf(mrun, rm);
        const float f = __builtin_amdgcn_exp2f(mrun - mnew);
        mrun = mnew;
        float ls = 0.f;
#pragma unroll
        for (int i = 0; i < 16; ++i) { p0[i] = __builtin_amdgcn_exp2f(p0[i] - mnew); p1[i] = __builtin_amdgcn_exp2f(p1[i] - mnew); ls += p0[i] + p1[i]; }
        lrun = lrun * f + ls;
        if (__any(f != 1.0f)) {
            if (hi == 0) wsf[r32] = f;
            __builtin_amdgcn_wave_barrier();
#pragma unroll
            for (int i = 0; i < 16; ++i) { const float fi = wsf[crow(i, hi)];
#pragma unroll
                for (int d = 0; d < 4; ++d) o[d][i] *= fi; }
            __builtin_amdgcn_wave_barrier();
        }
        bf16x8 pa[4]; pa[0] = pack8(p0, 0); pa[1] = pack8(p0, 1); pa[2] = pack8(p1, 0); pa[3] = pack8(p1, 1);
#pragma unroll
        for (int d0 = 0; d0 < 4; ++d0)
#pragma unroll
            for (int ks = 0; ks < 4; ++ks) {
                const LAS unsigned char* vp = Vb + (16 * ks + 4 * hi + q4) * RS + d0 * 64 + vcol;
                const s16x4 lo = vtr(vp), hh = vtr(vp + 8 * RS);
                const bf16x8 vf = __builtin_shufflevector(lo, hh, 0, 1, 2, 3, 4, 5, 6, 7);
                o[d0] = __builtin_amdgcn_mfma_f32_32x32x16_bf16(pa[ks], vf, o[d0], 0, 0, 0);
            }
    }
    lrun += __shfl_xor(lrun, 32);
    if (hi == 0) wsf[r32] = 1.0f / lrun;
    __builtin_amdgcn_wave_barrier();
#pragma unroll
    for (int i = 0; i < 16; ++i) { const float fi = wsf[crow(i, hi)];
#pragma unroll
        for (int d = 0; d < 4; ++d) o[d][i] *= fi; }
    __syncthreads();
    LAS float* X = (LAS float*)lds;
    if (map == 1) {
#pragma unroll
        for (int d = 0; d < 4; ++d)
#pragma unroll
            for (int i = 0; i < 16; ++i) X[(qs * 32 + crow(i, hi)) * 128 + 32 * d + r32] = o[d][i];
    }
    __syncthreads();
    if (map == 0) {
        float gsub[4];
#pragma unroll
        for (int d = 0; d < 4; ++d) gsub[d] = subg[32 * d + r32];
#pragma unroll
        for (int i = 0; i < 16; ++i) {
            float ss = 0.f;
#pragma unroll
            for (int d = 0; d < 4; ++d) { const float v = o[d][i] - lam_full * X[(qs * 32 + crow(i, hi)) * 128 + 32 * d + r32]; o[d][i] = v; ss += v * v; }
#pragma unroll
            for (int sft = 1; sft < 32; sft <<= 1) ss += __shfl_xor(ss, sft);
            const float rs = (1.0f / sqrtf(ss * (1.f / 128.f) + LN_EPS)) * oscale;
            bf16* orow = O + (rowbase + qmin + crow(i, hi)) * DM + 512 + h * 128 + r32;
#pragma unroll
            for (int d = 0; d < 4; ++d) orow[32 * d] = (bf16)f2bf(o[d][i] * rs * gsub[d]);
        }
    }
    __syncthreads();
}

__device__ __forceinline__ void cnt_ge(int& cnt, unsigned k, unsigned c) {
    asm volatile("v_cmp_ge_u32_e32 vcc, %1, %2\n\tv_addc_co_u32_e32 %0, vcc, 0, %0, vcc" : "+v"(cnt) : "v"(k), "v"(c) : "vcc");
}
__device__ __forceinline__ unsigned sel_addr(int& pos, unsigned k, unsigned p, unsigned base, unsigned dummy) {
    unsigned a;
    asm volatile("v_cmp_ge_u32_e32 vcc, %2, %3\n\tv_lshl_add_u32 %1, %0, 2, %4\n\tv_cndmask_b32_e32 %1, %5, %1, vcc\n\tv_addc_co_u32_e32 %0, vcc, 0, %0, vcc"
                 : "+v"(pos), "=&v"(a) : "v"(k), "v"(p), "v"(base), "v"(dummy) : "vcc");
    return a;
}
__device__ __forceinline__ void dsa_unit(unsigned char* ldsg, const bf16* P, const bf16* IK, bf16* O, float* scr, int b, int t0) {
    LAS unsigned char* lds = (LAS unsigned char*)ldsg;
    const int tid = launder_tid(), lane = tid & 63, wid = __builtin_amdgcn_readfirstlane(tid >> 6);
    const size_t rowbase = (size_t)b * SEQ;
    {
        const int c16 = lane & 15, g4 = lane >> 4;
        const bf16* qrow = P + (rowbase + t0 + c16) * PW;
        bf16x8 bq[8][2];
#pragma unroll
        for (int hh = 0; hh < 8; ++hh)
#pragma unroll
            for (int ks = 0; ks < 2; ++ks) bq[hh][ks] = *(const bf16x8*)(qrow + COL_IQ + hh * 64 + ks * 32 + 8 * g4);
        float w[8];
        { const u32x4 wv = *(const u32x4*)(qrow + COL_IW); w[0] = bflo(wv.x); w[1] = bfhi(wv.x); w[2] = bflo(wv.y); w[3] = bfhi(wv.y); w[4] = bflo(wv.z); w[5] = bfhi(wv.z); w[6] = bflo(wv.w); w[7] = bfhi(wv.w); }
        const int nkt = t0 / 16 + 1;
        for (int kt = wid; kt < nkt; kt += NWAVES) {
            const bf16* krow = IK + (rowbase + 16 * kt + c16) * 64 + 8 * g4;
            const bf16x8 a0 = *(const bf16x8*)krow, a1 = *(const bf16x8*)(krow + 32);
            f32x4 sc = {0.f, 0.f, 0.f, 0.f};
#pragma unroll
            for (int hh = 0; hh < 8; ++hh) {
                f32x4 z = {0.f, 0.f, 0.f, 0.f};
                z = __builtin_amdgcn_mfma_f32_16x16x32_bf16(a0, bq[hh][0], z, 0, 0, 0);
                z = __builtin_amdgcn_mfma_f32_16x16x32_bf16(a1, bq[hh][1], z, 0, 0, 0);
#pragma unroll
                for (int e = 0; e < 4; ++e) sc[e] += w[hh] * fmaxf(z[e], 0.f);
            }
            *(f32x4*)(scr + (size_t)c16 * SEQ + 16 * kt + 4 * g4) = sc;
        }
    }
    __syncthreads();
    LAS int* sel = (LAS int*)(lds + wid * 9728);
    LAS float* lg = (LAS float*)(lds + wid * 9728 + 1280);
    const LAS float* lutA = (const LAS float*)(lds + LDS_LUT);
    for (int qq = wid; qq < 16; qq += NWAVES) {
        const int t = t0 + qq;
        const float* row = scr + (size_t)qq * SEQ;
        unsigned k[128];
#pragma unroll
        for (int r = 0; r < 128; ++r) {
            unsigned key = 0u;
            const int tl = t - r * 64;
            if (tl >= 0) {
                const unsigned u = __builtin_bit_cast(unsigned, row[r * 64 + lane]); key = (u & 0x80000000u) ? ~u : (u | 0x80000000u);
                if (lane > tl) key = 0u;
            }
            k[r] = key;
        }
        unsigned pth = 1u, ptie = 0u; int nsel = t + 1, need = 0, cgt = 0;
        if (t >= 256) {
            pth = 0u; int cntge = 0;
            for (int bit = 31; bit >= 0; --bit) {
                const unsigned c = pth | (1u << bit);
                int c0 = 0;
#pragma unroll
                for (int r = 0; r < 128; ++r) cnt_ge(c0, k[r], c);
                const int cnt = wave_sum_i(c0);
                if (cnt >= 256) { pth = c; cntge = cnt; }
                if (cnt == 256) break;
            }
            nsel = 256;
            if (cntge != 256) {
                int c0 = 0;
#pragma unroll
                for (int r = 0; r < 128; ++r) cnt_ge(c0, k[r], pth + 1u);
                cgt = wave_sum_i(c0); need = 256 - cgt; ptie = pth; pth = pth + 1u;
            }
        }
        {
            int c0 = 0;
#pragma unroll
            for (int r = 0; r < 128; ++r) cnt_ge(c0, k[r], pth);
            int inc = c0;
#pragma unroll
            for (int o = 1; o < 64; o <<= 1) { const int v = __shfl_up(inc, o); if (lane >= o) inc += v; }
            int pos = inc - c0;
            const unsigned selb = (unsigned)(uintptr_t)sel, dummy = selb + 1024u + 4u * (unsigned)lane;
            int sval = lane;
#pragma unroll
            for (int r = 0; r < 128; ++r) { const unsigned a = sel_addr(pos, k[r], pth, selb, dummy); *(LAS int*)a = sval; asm volatile("v_add_u32_e32 %0, 64, %0" : "+v"(sval)); }
        }
        if (need > 0) {
            int filled = 0;
#pragma unroll 1
            for (int r = 0; r * 64 <= t && filled < need; ++r) {
                const int s = r * 64 + lane; unsigned key = 0u;
                if (s <= t) { const unsigned u = __builtin_bit_cast(unsigned, row[s]); key = (u & 0x80000000u) ? ~u : (u | 0x80000000u); }
                const bool eq = key == ptie;
                const unsigned long long me = __ballot(eq);
                const int pe = filled + (int)__builtin_amdgcn_mbcnt_hi((unsigned)(me >> 32), __builtin_amdgcn_mbcnt_lo((unsigned)me, 0u));
                if (eq && pe < need) sel[cgt + pe] = s;
                filled += __popcll(me);
            }
        }
        __builtin_amdgcn_wave_barrier();
        int ln = lane; asm volatile("" : "+v"(ln));
        const int hh = ln >> 3;
        float qf[8];
        { const u32x4 qv = *(const u32x4*)(P + (rowbase + t) * PW + COL_QA + ln * 8); const float SCQ = 0.125f * LOG2E;
          qf[0] = bflo(qv.x) * SCQ; qf[1] = bfhi(qv.x) * SCQ; qf[2] = bflo(qv.y) * SCQ; qf[3] = bfhi(qv.y) * SCQ; qf[4] = bflo(qv.z) * SCQ; qf[5] = bfhi(qv.z) * SCQ; qf[6] = bflo(qv.w) * SCQ; qf[7] = bfhi(qv.w) * SCQ; }
        const bf16* kbase = P + rowbase * PW + COL_KA + ln * 8;
        const bf16* vbase = P + rowbase * PW + COL_VA + ln * 8;
        const LAS float* lutH = lutA + hh * 129;
#pragma unroll 8
        for (int i = 0; i < nsel; ++i) {
            const int idx = sel[i];
            const u32x4 kv = *(const u32x4*)(kbase + (size_t)idx * PW);
            float d = qf[0] * bflo(kv.x) + qf[1] * bfhi(kv.x) + qf[2] * bflo(kv.y) + qf[3] * bfhi(kv.y) + qf[4] * bflo(kv.z) + qf[5] * bfhi(kv.z) + qf[6] * bflo(kv.w) + qf[7] * bfhi(kv.w);
            d += __shfl_xor(d, 1); d += __shfl_xor(d, 2); d += __shfl_xor(d, 4);
            const int n = t - idx;
            d += lutH[n > 128 ? 128 : n];
            if ((ln & 7) == 0) lg[i * 8 + hh] = d;
        }
        __builtin_amdgcn_wave_barrier();
        float mx = -INFINITY;
        for (int i = (ln & 7); i < nsel; i += 8) mx = fmaxf(mx, lg[i * 8 + hh]);
        mx = fmaxf(mx, __shfl_xor(mx, 1)); mx = fmaxf(mx, __shfl_xor(mx, 2)); mx = fmaxf(mx, __shfl_xor(mx, 4));
        float sm = 0.f;
        for (int i = (ln & 7); i < nsel; i += 8) { const float e = __builtin_amdgcn_exp2f(lg[i * 8 + hh] - mx); lg[i * 8 + hh] = e; sm += e; }
        sm += __shfl_xor(sm, 1); sm += __shfl_xor(sm, 2); sm += __shfl_xor(sm, 4);
        __builtin_amdgcn_wave_barrier();
        float acc[8];
#pragma unroll
        for (int e = 0; e < 8; ++e) acc[e] = 0.f;
#pragma unroll 8
        for (int i = 0; i < nsel; ++i) {
            const int idx = sel[i];
            const float pr = lg[i * 8 + hh];
            const u32x4 vv = *(const u32x4*)(vbase + (size_t)idx * PW);
            acc[0] += pr * bflo(vv.x); acc[1] += pr * bfhi(vv.x); acc[2] += pr * bflo(vv.y); acc[3] += pr * bfhi(vv.y);
            acc[4] += pr * bflo(vv.z); acc[5] += pr * bfhi(vv.z); acc[6] += pr * bflo(vv.w); acc[7] += pr * bfhi(vv.w);
        }
        const float inv = 1.0f / sm;
        u32x4 ow; ow.x = pk2(acc[0] * inv, acc[1] * inv); ow.y = pk2(acc[2] * inv, acc[3] * inv); ow.z = pk2(acc[4] * inv, acc[5] * inv); ow.w = pk2(acc[6] * inv, acc[7] * inv);
        *(u32x4*)(O + (rowbase + t) * DM + ln * 8) = ow;
        __builtin_amdgcn_wave_barrier();
    }
    __syncthreads();
}

__device__ __forceinline__ void att_phase(const Params& p, unsigned char* ldsg, int layer) {
    const int tid = launder_tid();
    const int j = layer >> 1;
    unsigned char* ws = p.ws;
    const bf16* P = (const bf16*)(ws + WS_PB); const bf16* IK = (const bf16*)(ws + WS_IK); bf16* O = (bf16*)(ws + WS_XB);
    float* scr = (float*)(ws + WS_SCR) + (size_t)blockIdx.x * 16 * SEQ;
    LAS float* lut = (LAS float*)((LAS unsigned char*)ldsg + LDS_LUT);
    LAS float* misc = lut + 12 * 129;
    const float* relb = p.in[5];
    for (int i = tid; i < 12 * 129; i += NTHREADS) { const int hd = i / 129, n = i % 129; lut[i] = relb[t5_bucket(n) * 12 + hd] * LOG2E; }
    if (tid < 64) {
        const float* lam = p.in[9] + (size_t)j * 4 * 64;
        const float a = wave_sum(lam[tid] * lam[64 + tid]), bb = wave_sum(lam[128 + tid] * lam[192 + tid]);
        if (tid == 0) misc[0] = a, misc[1] = bb;
    }
    __syncthreads();
    const float lam_init = 0.8f - 0.6f * expf(-0.3f * (float)layer);
    const float lam_full = expf(misc[0]) - expf(misc[1]) + lam_init;
    const float* subg = p.in[10] + (size_t)j * 128;
    for (int c = blockIdx.x; c < 256; c += gridDim.x) {
        const int b = c >> 7, h = (c >> 5) & 3, i = c & 31;
        if (EN_DIFF) diff_unit(ldsg, P, O, b, h, 63 - i, lam_full, 1.0f - lam_init, subg);
        if (EN_DIFF) diff_unit(ldsg, P, O, b, h, i, lam_full, 1.0f - lam_init, subg);
    }
    for (int c = blockIdx.x; c < 256; c += gridDim.x) {
#pragma unroll 1
        for (int kq = 0; kq < 4; ++kq) {
            const int id = (kq == 0) ? 1023 - c : (kq == 1) ? 512 + c : (kq == 2) ? 511 - c : c;
            if (EN_DSA) dsa_unit(ldsg, P, IK, O, scr, id & 1, (id >> 1) * 16);
        }
    }
}

__global__ void __launch_bounds__(NTHREADS, 2) fwd_kernel(Params p) {
    extern __shared__ __attribute__((aligned(16))) unsigned char lds[];
    cg::grid_group grid = cg::this_grid();
    unsigned char* ws = p.ws;
    bf16* XB = (bf16*)(ws + WS_XB); bf16* PB = (bf16*)(ws + WS_PB); float* Y = (float*)(ws + WS_Y);
    for (int ph = p.ph_lo; ph < p.ph_hi; ++ph) {
        if (ph > p.ph_lo) grid.sync();
        if (ph == 0) { if (EN_PRO) prologue_phase(p, lds); continue; }
        int l, s;
        if (ph < 12) { l = 0; s = ph - 1; } else if (ph < 22) { l = 1; s = ph - 12; } else if (ph < 33) { l = 2; s = ph - 22; } else { l = 3; s = ph - 33; }
        if ((l & 1) && s >= 4) s += 1;
        const int j = l >> 1;
        const float* base = (ph <= 2) ? p.in[0] : p.out;
        if (s == 0 || s == 8) {
            const int f = (s == 8);
            pg8::Gemm g{XB, (const bf16*)(ws + WS_WFI + (size_t)(l * 2 + f) * SZ_WFI), MTOK, 5632, 1024}; pg8::StaticOrder S; S.init(MTOK, 5632, gridDim.x, blockIdx.x);
            pg8::EpiAct E{PB, DFF, 0};
            if (EN_GEMM1) pg8::gemm_phase<pg8::EpiAct, pg8::StaticOrder, true, true>((PG8_LAS unsigned char*)lds, g, S, E);
        } else if (s == 3 && (l & 1)) {
            pg8::Gemm g{XB, (const bf16*)(ws + WS_WCI + (size_t)j * SZ_WCI), MTOK, 2048, 1024}; pg8::StaticOrder S; S.init(MTOK, 2048, gridDim.x, blockIdx.x);
            pg8::EpiAct E{PB, DM, 1};
            if (EN_GEMM1) pg8::gemm_phase<pg8::EpiAct, pg8::StaticOrder, true, true>((PG8_LAS unsigned char*)lds, g, S, E);
        } else if (s == 1 || s == 9) {
            const int f = (s == 9);
            pg8::Gemm g{PB, (const bf16*)(ws + WS_WFO + (size_t)(l * 2 + f) * SZ_WFO), MTOK, DM, DFF}; pg8::StaticOrder S; S.init(MTOK, DM, gridDim.x, blockIdx.x);
            pg8::EpiRes E{base, Y, DM, ALPHA, 0.5f};
            if (EN_GEMM2) pg8::gemm_phase<pg8::EpiRes, pg8::StaticOrder, true, true>((PG8_LAS unsigned char*)lds, g, S, E);
        } else if (s == 6) {
            const bf16* Wt = (l & 1) ? (const bf16*)(ws + WS_WCO + (size_t)j * SZ_WCO) : (const bf16*)(ws + WS_WMO + (size_t)j * SZ_WMO);
            pg8::Gemm g{XB, Wt, MTOK, DM, DM}; pg8::StaticOrder S; S.init(MTOK, DM, gridDim.x, blockIdx.x);
            pg8::EpiRes E{base, Y, DM, ALPHA, 1.0f};
            if (EN_GEMM2) pg8::gemm_phase<pg8::EpiRes, pg8::StaticOrder, true, true>((PG8_LAS unsigned char*)lds, g, S, E);
        } else if (s == 3) {
            pg8::Gemm g{XB, (const bf16*)(ws + WS_WMI + (size_t)j * SZ_WMI), MTOK, PW, 1024}; pg8::StaticOrder S; S.init(MTOK, PW, gridDim.x, blockIdx.x);
            pg8::EpiBf16 E{PB, PW};
            if (EN_GEMM3) pg8::gemm_phase<pg8::EpiBf16, pg8::StaticOrder, true, true>((PG8_LAS unsigned char*)lds, g, S, E);
        } else if (s == 2 || s == 7 || s == 10) {
            const int which = (s == 2) ? 0 : (s == 7) ? 1 : 2;
            if (EN_LN) ln_phase(Y, p.in[3] + (size_t)(l * 3 + which) * DM, p.in[4] + (size_t)(l * 3 + which) * DM, p.out, XB);
        } else if (s == 4) {
            if (EN_IKLN) ikln_phase(PB, p.in[7] + (size_t)j * 64, p.in[8] + (size_t)j * 64, (bf16*)(ws + WS_IK));
        } else if (s == 5 && !(l & 1)) {
            att_phase(p, lds, l);
        } else if (s == 5) {
            if (EN_CONV) conv_phase(PB, p.in[13] + (size_t)j * 31 * DM, p.in[14] + (size_t)j * DM, p.in[15] + (size_t)j * DM, p.in[16] + (size_t)j * DM, XB);
        }
    }
}
constexpr int NPHASES = 43;

#ifndef ONE_LAUNCH
#define ONE_LAUNCH 1
#endif
extern "C" void kernel_launch(void* const* d_in, const int* in_sizes, int n_in, void* d_out, int out_size, void* d_ws, size_t ws_size, hipStream_t stream) {
    static int grid = 0;
    if (grid == 0) {
        if (n_in != 18 || in_sizes[0] != MTOK * DM || out_size != MTOK * DM || ws_size < WS_END) { fprintf(stderr, "kernel_launch: unexpected shapes (n_in %d, in0 %d, out %d, ws %zu)\n", n_in, n_in > 0 ? in_sizes[0] : -1, out_size, ws_size); grid = -1; return; }
        int dev = 0, cus = 0, per_cu = 0;
        if (hipGetDevice(&dev) != hipSuccess || hipDeviceGetAttribute(&cus, hipDeviceAttributeMultiprocessorCount, dev) != hipSuccess) { grid = -1; return; }
        if (hipFuncSetAttribute((const void*)fwd_kernel, hipFuncAttributeMaxDynamicSharedMemorySize, LDS_BYTES) != hipSuccess) { fprintf(stderr, "kernel_launch: hipFuncSetAttribute failed\n"); grid = -1; return; }
        if (hipOccupancyMaxActiveBlocksPerMultiprocessor(&per_cu, (const void*)fwd_kernel, NTHREADS, LDS_BYTES) != hipSuccess || per_cu < 1) { fprintf(stderr, "kernel_launch: occupancy query gave %d\n", per_cu); per_cu = 1; }
        (void)hipGetLastError();
        grid = cus;
    }
    if (grid < 0) return;
    Params p{};
    for (int i = 0; i < 18; ++i) p.in[i] = (const float*)d_in[i];
    p.out = (float*)d_out; p.ws = (unsigned char*)d_ws;
#if ONE_LAUNCH
    p.ph_lo = 0; p.ph_hi = NPHASES;
    void* args[] = {&p};
    hipError_t e = hipLaunchCooperativeKernel((const void*)fwd_kernel, dim3(grid), dim3(NTHREADS), args, LDS_BYTES, stream);
    if (e != hipSuccess) fprintf(stderr, "cooperative launch failed: %s (grid %d)\n", hipGetErrorString(e), grid);
#else
    for (int ph = 0; ph < NPHASES; ++ph) { p.ph_lo = ph; p.ph_hi = ph + 1; hipLaunchKernelGGL(fwd_kernel, dim3(grid), dim3(NTHREADS), LDS_BYTES, stream, p); }
#endif
}
```

```cpp
#include <hip/hip_runtime.h>
#include <hip/hip_cooperative_groups.h>
#include <cstdio>
#include <cstdint>
#include <cmath>
namespace cg = cooperative_groups;
namespace pg8 {
#define PG8_LAS __attribute__((address_space(3)))
typedef unsigned short bf16_t;
typedef short bf16x8 __attribute__((ext_vector_type(8)));
typedef float f32x4 __attribute__((ext_vector_type(4)));
typedef unsigned u32x4 __attribute__((ext_vector_type(4)));
constexpr int BM = 256, BK = 64, HALF = 128, HTB = HALF * BK * 2  , STAGE_BYTES = 8 * HTB, NXCD = 8, WGM = 8;

__host__ __device__ __forceinline__ int lds_byte(int r, int c) { const int st = (r >> 4) * 2 + (c >> 5), rr = r & 15, cc = c & 31, ob = rr * 64 + cc * 2; return st * 1024 + (ob ^ (((ob >> 9) & 1) << 5)); }
__host__ __device__ __forceinline__ void stage_rc(int b, int& R, int& C) { const int st = b / 1024, sb = b % 1024, swz = sb ^ (((sb >> 9) & 1) << 5); R = (st >> 1) * 16 + swz / 64; C = (st & 1) * 32 + (swz % 64) / 2; }
__host__ __device__ __forceinline__ int perm32(int rho) { const int n = rho >> 4, i = rho & 15; return 8 * (i >> 2) + 4 * n + (i & 3); }

struct Unit { int pm, pn; };
struct Gemm { const bf16_t* A; const bf16_t* Bt; int M, N, K; };

struct StaticOrder {
    int nM, nN, nwg, G, c;
    __host__ __device__ void init(int M, int N, int G_, int c_) { nM = M / BM; nN = N / BM; nwg = nM * nN; G = G_; c = c_; }
    __host__ __device__ bool next(int i, Unit& u) const {
        const long L = (long)i * G + c; if (L >= nwg) return false;
        int wgid = (int)L; { const int q = nwg / NXCD, r = nwg % NXCD, xcd = wgid % NXCD, off = wgid / NXCD; wgid = (xcd < r ? xcd * (q + 1) : r * (q + 1) + (xcd - r) * q) + off; }
        const int nig = WGM * nN, gid = wgid / nig, fm = gid * WGM, gsz = (nM - fm) < WGM ? (nM - fm) : WGM;
        u.pm = fm + ((wgid % nig) % gsz); u.pn = (wgid % nig) / gsz; return true;
    }
    __device__ __forceinline__ void a_ready(const Unit&) const {}
    __device__ __forceinline__ void done(const Unit&) const {}
};

__device__ __forceinline__ unsigned cvt_pk_bf16(float lo, float hi) { unsigned r; asm volatile("v_cvt_pk_bf16_f32 %0, %1, %2" : "=v"(r) : "v"(lo), "v"(hi)); return r; }
typedef float f32x2 __attribute__((ext_vector_type(2)));
typedef unsigned u32x4 __attribute__((ext_vector_type(4)));
__device__ __forceinline__ float sigmoidf_fast(float x) { return __builtin_amdgcn_rcpf(1.0f + __builtin_amdgcn_exp2f(-1.4426950408889634f * x)); }
struct EpiBf16 {
    static constexpr bool PERM = true, AFTER_DRAIN = false;
    bf16_t* O; int ldc;
    __device__ __forceinline__ void operator()(const f32x4 (&acc)[2][2][4][2], const Unit& u, int wr, int wc, int fr, int fq) const {
        const int row0 = u.pm * BM + wr * 64 + fr; const int col0 = u.pn * BM + wc * 32 + 8 * fq;
#pragma unroll
        for (int ai = 0; ai < 2; ++ai)
#pragma unroll
            for (int m = 0; m < 4; ++m) { bf16_t* rowp = O + (size_t)(row0 + ai * HALF + m * 16) * ldc + col0;
#pragma unroll
                for (int bj = 0; bj < 2; ++bj) { const f32x4 v0 = acc[ai][bj][m][0], v1 = acc[ai][bj][m][1];
                    u32x4 w; w.x = cvt_pk_bf16(v0[0], v0[1]); w.y = cvt_pk_bf16(v0[2], v0[3]); w.z = cvt_pk_bf16(v1[0], v1[1]); w.w = cvt_pk_bf16(v1[2], v1[3]);
                    *(u32x4*)(rowp + bj * HALF) = w; } }
    }
};
struct EpiAct {
    static constexpr bool PERM = true, AFTER_DRAIN = false;
    bf16_t* O; int ldc; int mode;
    __device__ __forceinline__ void operator()(const f32x4 (&acc)[2][2][4][2], const Unit& u, int wr, int wc, int fr, int fq) const {
        const int row0 = u.pm * BM + wr * 64 + fr; const int col0 = u.pn * HALF + wc * 32 + 8 * fq;
#pragma unroll
        for (int ai = 0; ai < 2; ++ai)
#pragma unroll
            for (int m = 0; m < 4; ++m) { bf16_t* rowp = O + (size_t)(row0 + ai * HALF + m * 16) * ldc + col0;
                float r[8];
#pragma unroll
                for (int n = 0; n < 2; ++n)
#pragma unroll
                    for (int e = 0; e < 4; ++e) { const float a = acc[ai][0][m][n][e], b = acc[ai][1][m][n][e];
                        const float s = sigmoidf_fast(mode ? b : a); r[4 * n + e] = mode ? a * s : a * s * b; }
                u32x4 w; w.x = cvt_pk_bf16(r[0], r[1]); w.y = cvt_pk_bf16(r[2], r[3]); w.z = cvt_pk_bf16(r[4], r[5]); w.w = cvt_pk_bf16(r[6], r[7]);
                *(u32x4*)rowp = w; }
    }
};
struct EpiRes {
    static constexpr bool PERM = false, AFTER_DRAIN = false;
    const float* base; float* out; int ldc; float alpha, scale;
    __device__ __forceinline__ void operator()(const f32x4 (&acc)[2][2][4][2], const Unit& u, int wr, int wc, int fr, int fq) const {
        const int col0 = u.pn * BM + wc * 32 + 4 * fq;
#pragma unroll
        for (int ai = 0; ai < 2; ++ai)
#pragma unroll
            for (int m = 0; m < 4; ++m) { const int r = u.pm * BM + ai * HALF + wr * 64 + m * 16 + fr; const size_t off = (size_t)r * ldc + col0;
#pragma unroll
                for (int bj = 0; bj < 2; ++bj)
#pragma unroll
                    for (int n = 0; n < 2; ++n) { const f32x4 bs = *(const f32x4*)(base + off + bj * HALF + n * 16);
                        *(f32x4*)(out + off + bj * HALF + n * 16) = bs * alpha + acc[ai][bj][m][n] * scale; } }
    }
};
template <class Epi, class Sched, bool ALIGN_EPI = false, bool SP2 = false>
__device__ __forceinline__ void gemm_phase(PG8_LAS unsigned char* lds, const Gemm g, const Sched& S, const Epi& E) {
    int tid_ = threadIdx.x; asm volatile("" : "+v"(tid_));
    const int tid = tid_, wid = __builtin_amdgcn_readfirstlane(tid >> 6), lane = tid & 63, wr = wid >> 2, wc = wid & 3, fr = lane & 15, fq = lane >> 4;
    const int K = g.K, nt = K / BK;
    unsigned voffA[2], voffB[2];
#pragma unroll
    for (int i = 0; i < 2; ++i) { int R, C; stage_rc(tid * 16 + i * 8192, R, C); const int Rb = Epi::PERM ? ((R & ~31) + perm32(R & 31)) : R;
        voffA[i] = (unsigned)(R * K + C) * 2u; voffB[i] = (unsigned)(Rb * K + C) * 2u; }
    const size_t kstep = (size_t)(BK * 2);
    const size_t hstep = (size_t)HALF * K * 2;
    const size_t tstep = 2 * hstep;
    const unsigned ldsw = (unsigned)wid * 1024u;
    const int aoff = lds_byte(wr * 64 + fr, fq * 8), boff = lds_byte(wc * 32 + fr, fq * 8);
#define PG8_SA(b, h) (((b) * 2 + (h)) * HTB)
#define PG8_SB(b, h) ((4 + (b) * 2 + (h)) * HTB)
#define PG8_STAGE(bufoff, gbase, voff) do { _Pragma("unroll") for (int _i = 0; _i < 2; ++_i) \
        __builtin_amdgcn_global_load_lds((const unsigned*)((const char*)(gbase) + (voff)[_i]), (PG8_LAS unsigned*)(lds + (bufoff) + ldsw + _i * 8192), 16, 0, 0); } while (0)
#define PG8_LDA(dst, b, h) do { _Pragma("unroll") for (int m = 0; m < 4; ++m) _Pragma("unroll") for (int k = 0; k < 2; ++k) dst[m][k] = *(const PG8_LAS bf16x8*)(lds + PG8_SA(b, h) + aoff + m * 2048 + k * 1024); } while (0)
#define PG8_LDB(dst, b, h) do { _Pragma("unroll") for (int n = 0; n < 2; ++n) _Pragma("unroll") for (int k = 0; k < 2; ++k) dst[n][k] = *(const PG8_LAS bf16x8*)(lds + PG8_SB(b, h) + boff + n * 2048 + k * 1024); } while (0)
#define PG8_MMA(ai, bj, At, Bt) do { __builtin_amdgcn_s_setprio(1); _Pragma("unroll") for (int m = 0; m < 4; ++m) _Pragma("unroll") for (int n = 0; n < 2; ++n) _Pragma("unroll") for (int k = 0; k < 2; ++k) \
        acc[ai][bj][m][n] = __builtin_amdgcn_mfma_f32_16x16x32_bf16(Bt[n][k], At[m][k], acc[ai][bj][m][n], 0, 0, 0); __builtin_amdgcn_s_setprio(0); } while (0)
#define PG8_WAIT_V(n) asm volatile("s_waitcnt vmcnt(" #n ")" ::: "memory")
#define PG8_WAIT_L(n) asm volatile("s_waitcnt lgkmcnt(" #n ")" ::: "memory")
#define PG8_BAR __builtin_amdgcn_s_barrier()
#define PG8_SCHED __builtin_amdgcn_sched_barrier(0)
    Unit cur, nxt; int ui = 0;
    if (!S.next(0, cur)) return;
    f32x4 acc[2][2][4][2];
#pragma unroll
    for (int a = 0; a < 2; ++a)
#pragma unroll
        for (int b = 0; b < 2; ++b)
#pragma unroll
            for (int m = 0; m < 4; ++m)
#pragma unroll
                for (int n = 0; n < 2; ++n) acc[a][b][m][n] = (f32x4){0.f, 0.f, 0.f, 0.f};
    bf16x8 At[4][2], B0[2][2], B1[2][2];
    const char* cA = (const char*)g.A + (size_t)cur.pm * tstep; const char* cB = (const char*)g.Bt + (size_t)cur.pn * tstep;
    S.a_ready(cur);
    if constexpr (SP2) {
        PG8_STAGE(PG8_SB(0, 0), cB, voffB); PG8_STAGE(PG8_SB(0, 1), cB + hstep, voffB); PG8_STAGE(PG8_SA(0, 0), cA, voffA); PG8_STAGE(PG8_SA(0, 1), cA + hstep, voffA);
        if (wr == 1) PG8_BAR;
        PG8_WAIT_V(2); PG8_BAR;
        PG8_STAGE(PG8_SB(1, 0), cB + kstep, voffB); PG8_STAGE(PG8_SA(1, 0), cA + kstep, voffA); PG8_STAGE(PG8_SB(1, 1), cB + hstep + kstep, voffB);
        PG8_WAIT_V(6); PG8_BAR;
    } else {
        PG8_STAGE(PG8_SB(0, 0), cB, voffB); PG8_STAGE(PG8_SA(0, 0), cA, voffA); PG8_STAGE(PG8_SB(0, 1), cB + hstep, voffB); PG8_STAGE(PG8_SA(0, 1), cA + hstep, voffA);
        if (wr == 1) PG8_BAR;
        PG8_WAIT_V(4); PG8_BAR;
        PG8_STAGE(PG8_SB(1, 0), cB + kstep, voffB); PG8_STAGE(PG8_SA(1, 0), cA + kstep, voffA); PG8_STAGE(PG8_SB(1, 1), cB + hstep + kstep, voffB);
        PG8_WAIT_V(6); PG8_BAR;
    }
    for (;;) {
        const bool has_next = S.next(ui + 1, nxt);
        const char* nA = has_next ? (const char*)g.A + (size_t)nxt.pm * tstep : cA; const char* nB = has_next ? (const char*)g.Bt + (size_t)nxt.pn * tstep : cB;
        for (int t = 0; t < nt; t += 2) {
            const bool last = (t == nt - 2);
            const char* a1 = cA + (size_t)(t + 1) * kstep;
            const char* a2 = last ? nA : cA + (size_t)(t + 2) * kstep; const char* b2 = last ? nB : cB + (size_t)(t + 2) * kstep;
            const char* a3 = a2 + kstep; const char* b3 = b2 + kstep;
            if (last && has_next) S.a_ready(nxt);
            if constexpr (SP2) {
            PG8_LDB(B0, 0, 0); PG8_LDB(B1, 0, 1); PG8_SCHED; PG8_LDA(At, 0, 0); PG8_STAGE(PG8_SA(1, 1), a1 + hstep, voffA);
            PG8_WAIT_V(8); PG8_WAIT_L(0); PG8_BAR; PG8_MMA(0, 0, At, B0); PG8_MMA(0, 1, At, B1); PG8_BAR; PG8_SCHED;
            PG8_LDA(At, 0, 1); PG8_STAGE(PG8_SB(0, 0), b2, voffB); PG8_STAGE(PG8_SB(0, 1), b2 + hstep, voffB); PG8_STAGE(PG8_SA(0, 0), a2, voffA);
            PG8_WAIT_V(8); PG8_WAIT_L(0); PG8_BAR; PG8_MMA(1, 0, At, B0); PG8_MMA(1, 1, At, B1); PG8_BAR; PG8_SCHED;
            PG8_LDB(B0, 1, 0); PG8_LDB(B1, 1, 1); PG8_SCHED; PG8_LDA(At, 1, 0); PG8_STAGE(PG8_SA(0, 1), a2 + hstep, voffA);
            PG8_WAIT_V(8); PG8_WAIT_L(0); PG8_BAR; PG8_MMA(0, 0, At, B0); PG8_MMA(0, 1, At, B1); PG8_BAR; PG8_SCHED;
            PG8_LDA(At, 1, 1); PG8_STAGE(PG8_SB(1, 0), b3, voffB); PG8_STAGE(PG8_SB(1, 1), b3 + hstep, voffB); PG8_STAGE(PG8_SA(1, 0), a3, voffA);
            PG8_WAIT_V(8); PG8_WAIT_L(0); PG8_BAR; PG8_MMA(1, 0, At, B0); PG8_MMA(1, 1, At, B1); PG8_BAR; PG8_SCHED;
            } else {
            PG8_LDB(B0, 0, 0); PG8_SCHED; PG8_LDA(At, 0, 0); PG8_STAGE(PG8_SA(1, 1), a1 + hstep, voffA);
            PG8_WAIT_L(8); PG8_BAR; PG8_WAIT_L(0); PG8_MMA(0, 0, At, B0); PG8_BAR; PG8_SCHED;
            PG8_LDB(B1, 0, 1); PG8_STAGE(PG8_SB(0, 0), b2, voffB);
            PG8_BAR; PG8_WAIT_L(0); PG8_MMA(0, 1, At, B1); PG8_BAR;
            PG8_LDA(At, 0, 1); PG8_STAGE(PG8_SA(0, 0), a2, voffA);
            PG8_BAR; PG8_WAIT_L(0); PG8_MMA(1, 0, At, B0); PG8_BAR; PG8_SCHED;
            PG8_STAGE(PG8_SB(0, 1), b2 + hstep, voffB);
            PG8_WAIT_V(6); PG8_BAR; PG8_MMA(1, 1, At, B1); PG8_BAR;
            PG8_LDB(B0, 1, 0); PG8_SCHED; PG8_LDA(At, 1, 0); PG8_STAGE(PG8_SA(0, 1), a2 + hstep, voffA);
            PG8_WAIT_L(8); PG8_BAR; PG8_WAIT_L(0); PG8_MMA(0, 0, At, B0); PG8_BAR; PG8_SCHED;
            PG8_LDB(B1, 1, 1); PG8_STAGE(PG8_SB(1, 0), b3, voffB);
            PG8_BAR; PG8_WAIT_L(0); PG8_MMA(0, 1, At, B1); PG8_BAR;
            PG8_LDA(At, 1, 1); PG8_STAGE(PG8_SA(1, 0), a3, voffA);
            PG8_BAR; PG8_WAIT_L(0); PG8_MMA(1, 0, At, B0); PG8_BAR; PG8_SCHED;
            PG8_STAGE(PG8_SB(1, 1), b3 + hstep, voffB);
            PG8_WAIT_V(6); PG8_BAR; PG8_MMA(1, 1, At, B1); PG8_BAR;
            }
        }
        if constexpr (ALIGN_EPI) { if (wr == 0) PG8_BAR; }
        if constexpr (!Epi::AFTER_DRAIN) { E(acc, cur, wr, wc, fr, fq); S.done(cur); }
        if (!has_next) break;
#pragma unroll
        for (int a = 0; a < 2; ++a)
#pragma unroll
            for (int b = 0; b < 2; ++b)
#pragma unroll
                for (int m = 0; m < 4; ++m)
#pragma unroll
                    for (int n = 0; n < 2; ++n) acc[a][b][m][n] = (f32x4){0.f, 0.f, 0.f, 0.f};
        cur = nxt; cA = nA; cB = nB; ++ui;
        if constexpr (ALIGN_EPI) { if (wr == 1) PG8_BAR; }
    }
    PG8_WAIT_V(0);
    if constexpr (!ALIGN_EPI) { if (wr == 0) PG8_BAR; }
    PG8_BAR;
    if constexpr (Epi::AFTER_DRAIN) { E.fused(acc, cur, wr, wc, fr, fq, lds, wid, lane); S.done(cur); }
#undef PG8_SA
#undef PG8_SB
#undef PG8_STAGE
#undef PG8_LDA
#undef PG8_LDB
#undef PG8_MMA
#undef PG8_WAIT_V
#undef PG8_WAIT_L
#undef PG8_BAR
#undef PG8_SCHED
}
}
#ifndef DUP_DIFF
#define DUP_DIFF 1
#endif
#ifndef DUP_DSA
#define DUP_DSA 1
#endif
#ifndef DUP_ATTB
#define DUP_ATTB 1
#endif
#ifndef EN_MASK
#define EN_MASK 0xffff
#endif
#define EN_PRO ((EN_MASK) & 1)
#define EN_GEMM1 ((EN_MASK) & 2)
#define EN_GEMM2 ((EN_MASK) & 4)
#define EN_GEMM3 ((EN_MASK) & 8)
#define EN_LN ((EN_MASK) & 16)
#define EN_IKLN ((EN_MASK) & 32)
#define EN_CONV ((EN_MASK) & 64)
#define EN_DIFF ((EN_MASK) & 128)
#define EN_DSA ((EN_MASK) & 256)
constexpr int SEQ = 8192, NB = 2, MTOK = NB * SEQ, DM = 1024, DFF = 2816, DEPTH = 4;
constexpr int PW = 3840;
constexpr int COL_QA = 0, COL_KA = 512, COL_VA = 1024, COL_IQ = 1536, COL_QB = 2048, COL_KB = 2560, COL_VB = 3072, COL_IK = 3584, COL_IW = 3648;
constexpr int PMIX = 3656;
constexpr float LN_EPS = 1e-5f;
constexpr float ALPHA = 1.6817928305074290f;
constexpr float LOG2E = 1.4426950408889634f;
constexpr int NTHREADS = 512, NWAVES = 8;
constexpr size_t MiB = 1u << 20;
constexpr size_t WS_WFI = 0, SZ_WFI = 11 * MiB;
constexpr size_t WS_WFO = 88 * MiB, SZ_WFO = 5632 * 1024;
constexpr size_t WS_WMI = 132 * MiB, SZ_WMI = (size_t)PW * 1024 * 2;
constexpr size_t WS_WMO = 147 * MiB, SZ_WMO = 2 * MiB;
constexpr size_t WS_WCI = 151 * MiB, SZ_WCI = 4 * MiB;
constexpr size_t WS_WCO = 159 * MiB, SZ_WCO = 2 * MiB;
constexpr size_t WS_XB = 164 * MiB;
constexpr size_t WS_PB = 196 * MiB;
constexpr size_t WS_Y = 316 * MiB;
constexpr size_t WS_SCR = 380 * MiB;
constexpr size_t WS_IK = 508 * MiB;
constexpr size_t WS_BITS = 510 * MiB;
constexpr size_t WS_END = 526 * MiB;
constexpr int LDS_BYTES = 131072 + 8192;
constexpr int LDS_LUT = 131072;

typedef unsigned short bf16;
typedef short bf16x8 __attribute__((ext_vector_type(8)));
typedef short s16x4 __attribute__((ext_vector_type(4)));
typedef float f32x4 __attribute__((ext_vector_type(4)));
typedef float f32x16 __attribute__((ext_vector_type(16)));
typedef unsigned u32x4 __attribute__((ext_vector_type(4)));
typedef unsigned u32x2 __attribute__((ext_vector_type(2)));
#define LAS __attribute__((address_space(3)))

__device__ __forceinline__ unsigned f2bf(float f) { unsigned u = __builtin_bit_cast(unsigned, f); return (u + 0x7fffu + ((u >> 16) & 1u)) >> 16; }
__device__ __forceinline__ unsigned pk2(float lo, float hi) { return f2bf(lo) | (f2bf(hi) << 16); }
__device__ __forceinline__ float bflo(unsigned w) { return __builtin_bit_cast(float, w << 16); }
__device__ __forceinline__ float bfhi(unsigned w) { return __builtin_bit_cast(float, w & 0xffff0000u); }
__device__ __forceinline__ float wave_sum(float v) {
#pragma unroll
    for (int o = 1; o < 64; o <<= 1) v += __shfl_xor(v, o);
    return v;
}
__device__ __forceinline__ int launder_tid() { int t = threadIdx.x; asm volatile("" : "+v"(t)); return t; }
__device__ __forceinline__ int wave_sum_i(int v) {
#pragma unroll
    for (int o = 1; o < 64; o <<= 1) v += __shfl_xor(v, o);
    return v;
}
__device__ __forceinline__ int crow(int r, int hi) { return (r & 3) + 8 * (r >> 2) + 4 * hi; }

struct Params { const float* in[18]; float* out; unsigned char* ws; int ph_lo, ph_hi; };

__device__ __forceinline__ int dest_row(int n, int mode, int NH) {
    if (mode == 0) return n;
    if (mode == 1) { const int hf = n >= NH ? 1 : 0, nn = n - hf * NH; return (nn >> 7) * 256 + hf * 128 + (nn & 127); }
    if (n < 2048) return n;
    if (n < 2112) return COL_IK + (n - 2048);
    if (n < 2120) return COL_IW + (n - 2112);
    return COL_QB + (n - 2120);
}
__device__ __forceinline__ void transpose_item(const float* W, int K, int N, bf16* WT, int mode, LAS float* scr, int item, int lane) {
    const int nblk = (N + 31) / 32, kb = item / nblk, nb = item % nblk, k0 = 64 * kb, n0 = 32 * nb;
    const int nr = n0 + (lane & 31);
#pragma unroll 8
    for (int i = 0; i < 32; ++i) { const int kk = 2 * i + (lane >> 5); scr[kk * 33 + (lane & 31)] = nr < N ? W[(size_t)(k0 + kk) * N + nr] : 0.f; }
    asm volatile("s_waitcnt lgkmcnt(0)" ::: "memory");
    const int c = lane & 7;
#pragma unroll
    for (int j = 0; j < 4; ++j) { const int n = (lane >> 3) + 8 * j; const LAS float* s = scr + (8 * c) * 33 + n;
        u32x4 o; o.x = pk2(s[0 * 33], s[1 * 33]); o.y = pk2(s[2 * 33], s[3 * 33]); o.z = pk2(s[4 * 33], s[5 * 33]); o.w = pk2(s[6 * 33], s[7 * 33]);
        if (n0 + n < N) *(u32x4*)(WT + (size_t)dest_row(n0 + n, mode, N / 2) * K + k0 + 8 * c) = o; }
    asm volatile("s_waitcnt lgkmcnt(0)" ::: "memory");
}
__device__ __forceinline__ void prologue_phase(const Params& p, unsigned char* lds) {
    const int tid = launder_tid(), lane = tid & 63, wave = __builtin_amdgcn_readfirstlane(tid >> 6);
    LAS float* scr = (LAS float*)((LAS unsigned char*)lds + wave * 16384);
    const int gw = blockIdx.x * NWAVES + wave, NGW = gridDim.x * NWAVES;
    unsigned char* ws = p.ws;
    constexpr int I_FI = (1024 / 64) * (5632 / 32), I_FO = (2816 / 64) * (1024 / 32), I_MI = (1024 / 64) * ((PMIX + 31) / 32), I_SQ = (1024 / 64) * (1024 / 32), I_CI = (1024 / 64) * (2048 / 32);
    constexpr int T_FI = 8 * I_FI, T_FO = 8 * I_FO, T_MI = 2 * I_MI, T_MO = 2 * I_SQ, T_CI = 2 * I_CI, T_CO = 2 * I_SQ;
    constexpr int NITEMS = T_FI + T_FO + T_MI + T_MO + T_CI + T_CO;
    for (int it = gw; it < NITEMS; it += NGW) {
        int r = it;
        if (r < T_FI) { const int w = r / I_FI; transpose_item(p.in[1] + (size_t)w * 1024 * 5632, 1024, 5632, (bf16*)(ws + WS_WFI + w * SZ_WFI), 1, scr, r % I_FI, lane); continue; } r -= T_FI;
        if (r < T_FO) { const int w = r / I_FO; transpose_item(p.in[2] + (size_t)w * 2816 * 1024, 2816, 1024, (bf16*)(ws + WS_WFO + w * SZ_WFO), 0, scr, r % I_FO, lane); continue; } r -= T_FO;
        if (r < T_MI) { const int w = r / I_MI; transpose_item(p.in[6] + (size_t)w * 1024 * PMIX, 1024, PMIX, (bf16*)(ws + WS_WMI + w * SZ_WMI), 2, scr, r % I_MI, lane); continue; } r -= T_MI;
        if (r < T_MO) { const int w = r / I_SQ; transpose_item(p.in[11] + (size_t)w * 1024 * 1024, 1024, 1024, (bf16*)(ws + WS_WMO + w * SZ_WMO), 0, scr, r % I_SQ, lane); continue; } r -= T_MO;
        if (r < T_CI) { const int w = r / I_CI; transpose_item(p.in[12] + (size_t)w * 1024 * 2048, 1024, 2048, (bf16*)(ws + WS_WCI + w * SZ_WCI), 1, scr, r % I_CI, lane); continue; } r -= T_CI;
        { const int w = r / I_SQ; transpose_item(p.in[17] + (size_t)w * 1024 * 1024, 1024, 1024, (bf16*)(ws + WS_WCO + w * SZ_WCO), 0, scr, r % I_SQ, lane); }
    }
    const float* x = p.in[0]; bf16* xb = (bf16*)(ws + WS_XB);
    for (int m = gw; m < MTOK; m += NGW) {
        const f32x4* xr = (const f32x4*)(x + (size_t)m * DM) + lane; u32x2* o = (u32x2*)(xb + (size_t)m * DM) + lane;
#pragma unroll
        for (int j = 0; j < 4; ++j) { const f32x4 v = xr[64 * j]; u32x2 w; w.x = pk2(v.x, v.y); w.y = pk2(v.z, v.w); o[64 * j] = w; }
    }
}
__device__ __forceinline__ void ln_phase(const float* Y, const float* g, const float* bta, float* X, bf16* XB) {
    const int tid = launder_tid(), lane = tid & 63, wave = __builtin_amdgcn_readfirstlane(tid >> 6);
    const int gw = blockIdx.x * NWAVES + wave, NGW = gridDim.x * NWAVES;
    f32x4 gv[4], bv[4];
#pragma unroll
    for (int j = 0; j < 4; ++j) { gv[j] = ((const f32x4*)g)[lane + 64 * j]; bv[j] = ((const f32x4*)bta)[lane + 64 * j]; }
    for (int m = gw; m < MTOK; m += NGW) {
        const f32x4* yr = (const f32x4*)(Y + (size_t)m * DM) + lane;
        f32x4 v[4]; float s = 0.f;
#pragma unroll
        for (int j = 0; j < 4; ++j) { v[j] = yr[64 * j]; s += (v[j].x + v[j].y) + (v[j].z + v[j].w); }
        const float mean = wave_sum(s) * (1.f / DM); float s2 = 0.f;
#pragma unroll
        for (int j = 0; j < 4; ++j) { v[j] = v[j] - mean; s2 += (v[j].x * v[j].x + v[j].y * v[j].y) + (v[j].z * v[j].z + v[j].w * v[j].w); }
        const float rstd = 1.0f / sqrtf(wave_sum(s2) * (1.f / DM) + LN_EPS);
        f32x4* xo = (f32x4*)(X + (size_t)m * DM) + lane; u32x2* bo = (u32x2*)(XB + (size_t)m * DM) + lane;
#pragma unroll
        for (int j = 0; j < 4; ++j) { const f32x4 o = v[j] * rstd * gv[j] + bv[j]; xo[64 * j] = o; u32x2 w; w.x = pk2(o.x, o.y); w.y = pk2(o.z, o.w); bo[64 * j] = w; }
    }
}
__device__ __forceinline__ void ikln_phase(const bf16* P, const float* g, const float* bta, bf16* IK) {
    const int gt = blockIdx.x * NTHREADS + launder_tid(), NT = gridDim.x * NTHREADS;
    for (int m = gt; m < MTOK; m += NT) {
        const u32x4* src = (const u32x4*)(P + (size_t)m * PW + COL_IK);
        float v[64]; float s = 0.f;
#pragma unroll
        for (int c = 0; c < 8; ++c) { const u32x4 w = src[c];
            v[8 * c + 0] = bflo(w.x); v[8 * c + 1] = bfhi(w.x); v[8 * c + 2] = bflo(w.y); v[8 * c + 3] = bfhi(w.y);
            v[8 * c + 4] = bflo(w.z); v[8 * c + 5] = bfhi(w.z); v[8 * c + 6] = bflo(w.w); v[8 * c + 7] = bfhi(w.w); }
#pragma unroll
        for (int i = 0; i < 64; ++i) s += v[i];
        const float mean = s * (1.f / 64.f); float s2 = 0.f;
#pragma unroll
        for (int i = 0; i < 64; ++i) { v[i] -= mean; s2 += v[i] * v[i]; }
        const float rstd = 1.0f / sqrtf(s2 * (1.f / 64.f) + LN_EPS);
        u32x4* dst = (u32x4*)(IK + (size_t)m * 64);
#pragma unroll
        for (int c = 0; c < 8; ++c) { u32x4 w;
            w.x = pk2(v[8 * c + 0] * rstd * g[8 * c + 0] + bta[8 * c + 0], v[8 * c + 1] * rstd * g[8 * c + 1] + bta[8 * c + 1]);
            w.y = pk2(v[8 * c + 2] * rstd * g[8 * c + 2] + bta[8 * c + 2], v[8 * c + 3] * rstd * g[8 * c + 3] + bta[8 * c + 3]);
            w.z = pk2(v[8 * c + 4] * rstd * g[8 * c + 4] + bta[8 * c + 4], v[8 * c + 5] * rstd * g[8 * c + 5] + bta[8 * c + 5]);
            w.w = pk2(v[8 * c + 6] * rstd * g[8 * c + 6] + bta[8 * c + 6], v[8 * c + 7] * rstd * g[8 * c + 7] + bta[8 * c + 7]);
            dst[c] = w; }
    }
}
__device__ __forceinline__ void conv_phase(const bf16* U, const float* dw, const float* dwb, const float* g, const float* bta, bf16* V) {
    const int tid = launder_tid(), lane = tid & 63, wave = __builtin_amdgcn_readfirstlane(tid >> 6);
    const int gw = blockIdx.x * NWAVES + wave, NGW = gridDim.x * NWAVES;
    for (int m = gw; m < MTOK; m += NGW) {
        const int t = m & (SEQ - 1);
        float acc[16];
#pragma unroll
        for (int jj = 0; jj < 2; ++jj) { const int c0 = lane * 8 + 512 * jj; const f32x4 b0 = *(const f32x4*)(dwb + c0), b1 = *(const f32x4*)(dwb + c0 + 4);
            acc[8 * jj + 0] = b0.x; acc[8 * jj + 1] = b0.y; acc[8 * jj + 2] = b0.z; acc[8 * jj + 3] = b0.w; acc[8 * jj + 4] = b1.x; acc[8 * jj + 5] = b1.y; acc[8 * jj + 6] = b1.z; acc[8 * jj + 7] = b1.w; }
        const int j0 = t >= 30 ? 0 : 30 - t;
        for (int j = j0; j < 31; ++j) {
            const bf16* urow = U + (size_t)(m - 30 + j) * DM; const float* wrow = dw + (size_t)j * DM;
#pragma unroll
            for (int jj = 0; jj < 2; ++jj) { const int c0 = lane * 8 + 512 * jj; const u32x4 u = *(const u32x4*)(urow + c0); const f32x4 w0 = *(const f32x4*)(wrow + c0), w1 = *(const f32x4*)(wrow + c0 + 4);
                acc[8 * jj + 0] += bflo(u.x) * w0.x; acc[8 * jj + 1] += bfhi(u.x) * w0.y; acc[8 * jj + 2] += bflo(u.y) * w0.z; acc[8 * jj + 3] += bfhi(u.y) * w0.w;
                acc[8 * jj + 4] += bflo(u.z) * w1.x; acc[8 * jj + 5] += bfhi(u.z) * w1.y; acc[8 * jj + 6] += bflo(u.w) * w1.z; acc[8 * jj + 7] += bfhi(u.w) * w1.w; }
        }
        float s = 0.f;
#pragma unroll
        for (int i = 0; i < 16; ++i) s += acc[i];
        const float mean = wave_sum(s) * (1.f / DM); float s2 = 0.f;
#pragma unroll
        for (int i = 0; i < 16; ++i) { acc[i] -= mean; s2 += acc[i] * acc[i]; }
        const float rstd = 1.0f / sqrtf(wave_sum(s2) * (1.f / DM) + LN_EPS);
#pragma unroll
        for (int jj = 0; jj < 2; ++jj) { const int c0 = lane * 8 + 512 * jj; float o[8];
#pragma unroll
            for (int e = 0; e < 8; ++e) { const float y = acc[8 * jj + e] * rstd * g[c0 + e] + bta[c0 + e]; o[e] = y * pg8::sigmoidf_fast(y); }
            u32x4 w; w.x = pk2(o[0], o[1]); w.y = pk2(o[2], o[3]); w.z = pk2(o[4], o[5]); w.w = pk2(o[6], o[7]);
            *(u32x4*)(V + (size_t)m * DM + c0) = w; }
    }
}
__device__ __forceinline__ int t5_bucket(int n) {
    if (n < 16) return n;
    int v = 16 + (int)(logf((float)n / 16.0f) / logf(8.0f) * 16.0f);
    return v < 31 ? v : 31;
}
__device__ __forceinline__ unsigned cvtpk(float lo, float hi) { typedef float f2 __attribute__((ext_vector_type(2))); typedef __bf16 b2 __attribute__((ext_vector_type(2))); f2 v = {lo, hi}; b2 b = __builtin_convertvector(v, b2); return __builtin_bit_cast(unsigned, b); }
__device__ __forceinline__ bf16x8 pack8(const f32x16& x, int s) {
    u32x4 p; p.x = cvtpk(x[8 * s + 0], x[8 * s + 1]); p.y = cvtpk(x[8 * s + 2], x[8 * s + 3]); p.z = cvtpk(x[8 * s + 4], x[8 * s + 5]); p.w = cvtpk(x[8 * s + 6], x[8 * s + 7]);
    return __builtin_bit_cast(bf16x8, p);
}
typedef short v4i16_t __attribute__((ext_vector_type(4)));
__device__ __forceinline__ s16x4 vtr(const LAS unsigned char* p) { return __builtin_bit_cast(s16x4, __builtin_amdgcn_ds_read_tr16_b64_v4i16((LAS v4i16_t*)p)); }

__device__ __forceinline__ void diff_unit(unsigned char* ldsg, const bf16* P, bf16* O, int b, int h, int qb, float lam_full, float oscale, const float* subg) {
    LAS unsigned char* lds = (LAS unsigned char*)ldsg;
    const int tid = launder_tid(), lane = tid & 63, wid = __builtin_amdgcn_readfirstlane(tid >> 6), r32 = lane & 31, hi = lane >> 5;
    const int map = wid >> 2, qs = wid & 3;
    const int q0 = qb * 128, qmin = q0 + qs * 32, myq = qmin + r32;
    const size_t rowbase = (size_t)b * SEQ;
    constexpr int RS = 272, TILE = 64 * RS;
    LAS float* wsf = (LAS float*)(lds + 4 * TILE) + wid * 32;
    const LAS float* lut = (const LAS float*)(lds + LDS_LUT) + (8 + h) * 129;
    bf16x8 qr[4];
    { const bf16* qp = P + (rowbase + myq) * PW + COL_QB + h * 128 + map * 64 + hi * 8;
#pragma unroll
      for (int d0 = 0; d0 < 4; ++d0) qr[d0] = *(const bf16x8*)(qp + d0 * 16); }
    const int NT = 2 * qb + 2;
    f32x16 o[4];
#pragma unroll
    for (int d = 0; d < 4; ++d)
#pragma unroll
        for (int i = 0; i < 16; ++i) o[d][i] = 0.f;
    float mrun = -INFINITY, lrun = 0.f;
    const float SC = 0.125f * LOG2E;
    const int lrow0 = tid >> 4, lc16 = tid & 15;
    const bf16* kg = P + (rowbase + lrow0) * PW + COL_KB + h * 128 + lc16 * 8;
    const bf16* vg = P + (rowbase + lrow0) * PW + COL_VB + h * 128 + lc16 * 8;
    u32x4 kr[2], vr[2];
#pragma unroll
    for (int i = 0; i < 2; ++i) { kr[i] = *(const u32x4*)(kg + (size_t)(32 * i) * PW); vr[i] = *(const u32x4*)(vg + (size_t)(32 * i) * PW); }
    const int q4 = (lane & 15) >> 2;
    const int vcol = (16 * ((lane >> 4) & 1) + 4 * (lane & 3)) * 2;
    for (int t = 0; t < NT; ++t) {
        const int buf = t & 1;
        LAS unsigned char* Kb = lds + buf * TILE; LAS unsigned char* Vb = lds + (2 + buf) * TILE;
#pragma unroll
        for (int i = 0; i < 2; ++i) { *(LAS u32x4*)(Kb + (lrow0 + 32 * i) * RS + lc16 * 16) = kr[i]; *(LAS u32x4*)(Vb + (lrow0 + 32 * i) * RS + lc16 * 16) = vr[i]; }
        __syncthreads();
        if (t + 1 < NT) {
#pragma unroll
            for (int i = 0; i < 2; ++i) { kr[i] = *(const u32x4*)(kg + (size_t)(64 * (t + 1) + 32 * i) * PW); vr[i] = *(const u32x4*)(vg + (size_t)(64 * (t + 1) + 32 * i) * PW); }
        }
        const int kb0 = 64 * t;
        if (kb0 > qmin + 31) continue;
        f32x16 p0, p1;
#pragma unroll
        for (int i = 0; i < 16; ++i) { p0[i] = 0.f; p1[i] = 0.f; }
#pragma unroll
        for (int d0 = 0; d0 < 4; ++d0) {
            const bf16x8 a0 = *(const LAS bf16x8*)(Kb + r32 * RS + (map * 64 + d0 * 16 + hi * 8) * 2);
            const bf16x8 a1 = *(const LAS bf16x8*)(Kb + (32 + r32) * RS + (map * 64 + d0 * 16 + hi * 8) * 2);
            p0 = __builtin_amdgcn_mfma_f32_32x32x16_bf16(a0, qr[d0], p0, 0, 0, 0);
            p1 = __builtin_amdgcn_mfma_f32_32x32x16_bf16(a1, qr[d0], p1, 0, 0, 0);
        }
        if (qmin - (kb0 + 63) >= 128) {
            const float c = lut[128];
#pragma unroll
            for (int i = 0; i < 16; ++i) { p0[i] = p0[i] * SC + c; p1[i] = p1[i] * SC + c; }
        } else {
#pragma unroll
            for (int i = 0; i < 16; ++i) {
                const int n0 = myq - (kb0 + crow(i, hi)), n1 = n0 - 32;
                const float b0 = lut[n0 < 0 ? 0 : (n0 > 128 ? 128 : n0)], b1 = lut[n1 < 0 ? 0 : (n1 > 128 ? 128 : n1)];
                p0[i] = n0 < 0 ? -INFINITY : p0[i] * SC + b0; p1[i] = n1 < 0 ? -INFINITY : p1[i] * SC + b1;
            }
        }
        float rm = fmaxf(p0[0], p1[0]);
#pragma unroll
        for (int i = 1; i < 16; ++i) rm = fmaxf(rm, fmaxf(p0[i], p1[i]));
        rm = fmaxf(rm, __shfl_xor(rm, 32));
        const float mnew = fmaxf(mrun, rm);
        const float f = __builtin_amdgcn_exp2f(mrun - mnew);
        mrun = mnew;
        float ls = 0.f;
#pragma unroll
        for (int i = 0; i < 16; ++i) { p0[i] = __builtin_amdgcn_exp2f(p0[i] - mnew); p1[i] = __builtin_amdgcn_exp2f(p1[i] - mnew); ls += p0[i] + p1[i]; }
        lrun = lrun * f + ls;
        if (__any(f != 1.0f)) {
            if (hi == 0) wsf[r32] = f;
            __builtin_amdgcn_wave_barrier();
#pragma unroll
            for (int i = 0; i < 16; ++i) { const float fi = wsf[crow(i, hi)];
#pragma unroll
                for (int d = 0; d < 4; ++d) o[d][i] *= fi; }
            __builtin_amdgcn_wave_barrier();
        }
        bf16x8 pa[4]; pa[0] = pack8(p0, 0); pa[1] = pack8(p0, 1); pa[2] = pack8(p1, 0); pa[3] = pack8(p1, 1);
#pragma unroll
        for (int d0 = 0; d0 < 4; ++d0)
#pragma unroll
            for (int ks = 0; ks < 4; ++ks) {
                const LAS unsigned char* vp = Vb + (16 * ks + 4 * hi + q4) * RS + d0 * 64 + vcol;
                const s16x4 lo = vtr(vp), hh = vtr(vp + 8 * RS);
                const bf16x8 vf = __builtin_shufflevector(lo, hh, 0, 1, 2, 3, 4, 5, 6, 7);
                o[d0] = __builtin_amdgcn_mfma_f32_32x32x16_bf16(pa[ks], vf, o[d0], 0, 0, 0);
            }
    }
    lrun += __shfl_xor(lrun, 32);
    if (hi == 0) wsf[r32] = 1.0f / lrun;
    __builtin_amdgcn_wave_barrier();
#pragma unroll
    for (int i = 0; i < 16; ++i) { const float fi = wsf[crow(i, hi)];
#pragma unroll
        for (int d = 0; d < 4; ++d) o[d][i] *= fi; }
    __syncthreads();
    LAS float* X = (LAS float*)lds;
    if (map == 1) {
#pragma unroll
        for (int d = 0; d < 4; ++d)
#pragma unroll
            for (int i = 0; i < 16; ++i) X[(qs * 32 + crow(i, hi)) * 128 + 32 * d + r32] = o[d][i];
    }
    __syncthreads();
    if (map == 0) {
        float gsub[4];
#pragma unroll
        for (int d = 0; d < 4; ++d) gsub[d] = subg[32 * d + r32];
#pragma unroll
        for (int i = 0; i < 16; ++i) {
            float ss = 0.f;
#pragma unroll
            for (int d = 0; d < 4; ++d) { const float v = o[d][i] - lam_full * X[(qs * 32 + crow(i, hi)) * 128 + 32 * d + r32]; o[d][i] = v; ss += v * v; }
#pragma unroll
            for (int sft = 1; sft < 32; sft <<= 1) ss += __shfl_xor(ss, sft);
            const float rs = (1.0f / sqrtf(ss * (1.f / 128.f) + LN_EPS)) * oscale;
            bf16* orow = O + (rowbase + qmin + crow(i, hi)) * DM + 512 + h * 128 + r32;
#pragma unroll
            for (int d = 0; d < 4; ++d) orow[32 * d] = (bf16)f2bf(o[d][i] * rs * gsub[d]);
        }
    }
    __syncthreads();
}

__device__ __forceinline__ void cnt_ge(int& cnt, unsigned k, unsigned c) {
    asm volatile("v_cmp_ge_u32_e32 vcc, %1, %2\n\tv_addc_co_u32_e32 %0, vcc, 0, %0, vcc" : "+v"(cnt) : "v"(k), "v"(c) : "vcc");
}
__device__ __forceinline__ unsigned sel_addr(int& pos, unsigned k, unsigned p, unsigned base, unsigned dummy) {
    unsigned a;
    asm volatile("v_cmp_ge_u32_e32 vcc, %2, %3\n\tv_lshl_add_u32 %1, %0, 2, %4\n\tv_cndmask_b32_e32 %1, %5, %1, vcc\n\tv_addc_co_u32_e32 %0, vcc, 0, %0, vcc"
                 : "+v"(pos), "=&v"(a) : "v"(k), "v"(p), "v"(base), "v"(dummy) : "vcc");
    return a;
}
__device__ __forceinline__ void dsa_unit(unsigned char* ldsg, const bf16* P, const bf16* IK, unsigned long long* bits, float* scr, int b, int t0) {
    LAS unsigned char* lds = (LAS unsigned char*)ldsg;
    const int tid = launder_tid(), lane = tid & 63, wid = __builtin_amdgcn_readfirstlane(tid >> 6);
    const size_t rowbase = (size_t)b * SEQ;
    {
        const int c16 = lane & 15, g4 = lane >> 4;
        const bf16* qrow = P + (rowbase + t0 + c16) * PW;
        bf16x8 bq[8][2];
#pragma unroll
        for (int hh = 0; hh < 8; ++hh)
#pragma unroll
            for (int ks = 0; ks < 2; ++ks) bq[hh][ks] = *(const bf16x8*)(qrow + COL_IQ + hh * 64 + ks * 32 + 8 * g4);
        float w[8];
        { const u32x4 wv = *(const u32x4*)(qrow + COL_IW); w[0] = bflo(wv.x); w[1] = bfhi(wv.x); w[2] = bflo(wv.y); w[3] = bfhi(wv.y); w[4] = bflo(wv.z); w[5] = bfhi(wv.z); w[6] = bflo(wv.w); w[7] = bfhi(wv.w); }
        const int nkt = t0 / 16 + 1;
        for (int kt = wid; kt < nkt; kt += NWAVES) {
            const bf16* krow = IK + (rowbase + 16 * kt + c16) * 64 + 8 * g4;
            const bf16x8 a0 = *(const bf16x8*)krow, a1 = *(const bf16x8*)(krow + 32);
            f32x4 sc = {0.f, 0.f, 0.f, 0.f};
#pragma unroll
            for (int hh = 0; hh < 8; ++hh) {
                f32x4 z = {0.f, 0.f, 0.f, 0.f};
                z = __builtin_amdgcn_mfma_f32_16x16x32_bf16(a0, bq[hh][0], z, 0, 0, 0);
                z = __builtin_amdgcn_mfma_f32_16x16x32_bf16(a1, bq[hh][1], z, 0, 0, 0);
#pragma unroll
                for (int e = 0; e < 4; ++e) sc[e] += w[hh] * fmaxf(z[e], 0.f);
            }
            *(f32x4*)(scr + (size_t)c16 * SEQ + 16 * kt + 4 * g4) = sc;
        }
    }
    __syncthreads();
    for (int qq = wid; qq < 16; qq += NWAVES) {
        const int t = t0 + qq;
        const float* row = scr + (size_t)qq * SEQ;
        unsigned k[128];
#pragma unroll
        for (int r = 0; r < 128; ++r) {
            unsigned key = 0u;
            const int tl = t - r * 64;
            if (tl >= 0) {
                const unsigned u = __builtin_bit_cast(unsigned, row[r * 64 + lane]); key = (u & 0x80000000u) ? ~u : (u | 0x80000000u);
                if (lane > tl) key = 0u;
            }
            k[r] = key;
        }
        unsigned pth = 1u, ptie = 0u; int need = 0, cgt = 0;
        if (t >= 256) {
            pth = 0u; int cntge = 0;
            for (int bit = 31; bit >= 0; --bit) {
                const unsigned c = pth | (1u << bit);
                int c0 = 0;
#pragma unroll
                for (int r = 0; r < 128; ++r) cnt_ge(c0, k[r], c);
                const int cnt = wave_sum_i(c0);
                if (cnt >= 256) { pth = c; cntge = cnt; }
                if (cnt == 256) break;
            }
            if (cntge != 256) {
                int c0 = 0;
#pragma unroll
                for (int r = 0; r < 128; ++r) cnt_ge(c0, k[r], pth + 1u);
                cgt = wave_sum_i(c0); need = 256 - cgt; ptie = pth; pth = pth + 1u;
            }
        }
        {
            unsigned w0lo = 0u, w0hi = 0u, w1lo = 0u, w1hi = 0u;
#define WL1(r) { const unsigned long long m0 = __ballot(k[r] >= pth), m1 = __ballot(k[(r) + 64] >= pth); \
                asm volatile("v_writelane_b32 %0, %1, " #r : "+v"(w0lo) : "s"((unsigned)m0)); asm volatile("v_writelane_b32 %0, %1, " #r : "+v"(w0hi) : "s"((unsigned)(m0 >> 32))); \
                asm volatile("v_writelane_b32 %0, %1, " #r : "+v"(w1lo) : "s"((unsigned)m1)); asm volatile("v_writelane_b32 %0, %1, " #r : "+v"(w1hi) : "s"((unsigned)(m1 >> 32))); \
                __builtin_amdgcn_sched_barrier(0); }
#define WL8(a) WL1(a##0) WL1(a##1) WL1(a##2) WL1(a##3) WL1(a##4) WL1(a##5) WL1(a##6) WL1(a##7)
            WL1(0) WL1(1) WL1(2) WL1(3) WL1(4) WL1(5) WL1(6) WL1(7) WL1(8) WL1(9)
            WL1(10) WL1(11) WL1(12) WL1(13) WL1(14) WL1(15) WL1(16) WL1(17) WL1(18) WL1(19)
            WL1(20) WL1(21) WL1(22) WL1(23) WL1(24) WL1(25) WL1(26) WL1(27) WL1(28) WL1(29)
            WL1(30) WL1(31) WL1(32) WL1(33) WL1(34) WL1(35) WL1(36) WL1(37) WL1(38) WL1(39)
            WL1(40) WL1(41) WL1(42) WL1(43) WL1(44) WL1(45) WL1(46) WL1(47) WL1(48) WL1(49)
            WL1(50) WL1(51) WL1(52) WL1(53) WL1(54) WL1(55) WL1(56) WL1(57) WL1(58) WL1(59)
            WL1(60) WL1(61) WL1(62) WL1(63)
#undef WL1
#undef WL8
            u32x2* brow = (u32x2*)(bits + (rowbase + t) * 128);
            u32x2 v0; v0.x = w0lo; v0.y = w0hi; u32x2 v1; v1.x = w1lo; v1.y = w1hi;
            brow[lane] = v0; brow[64 + lane] = v1;
        }
        if (need > 0) {
            asm volatile("s_waitcnt vmcnt(0)" ::: "memory");
            int filled = 0;
#pragma unroll 1
            for (int r = 0; r * 64 <= t && filled < need; ++r) {
                const int s = r * 64 + lane; unsigned key = 0u;
                if (s <= t) { const unsigned u = __builtin_bit_cast(unsigned, row[s]); key = (u & 0x80000000u) ? ~u : (u | 0x80000000u); }
                const bool eq = key == ptie;
                const unsigned long long me = __ballot(eq);
                const int pe = filled + (int)__builtin_amdgcn_mbcnt_hi((unsigned)(me >> 32), __builtin_amdgcn_mbcnt_lo((unsigned)me, 0u));
                const unsigned long long take = __ballot(eq && pe < need);
                if (lane == 0 && take != 0ull) atomicOr(bits + (rowbase + t) * 128 + r, take);
                filled += __popcll(me);
            }
        }
    }
    __syncthreads();
}

__device__ __forceinline__ void dsa_attn_unit(unsigned char* ldsg, const bf16* P, const unsigned long long* bits, bf16* O, int b, int h, int qb) {
    LAS unsigned char* lds = (LAS unsigned char*)ldsg;
    const int tid = launder_tid(), lane = tid & 63, wid = __builtin_amdgcn_readfirstlane(tid >> 6), r32 = lane & 31, hi = lane >> 5;
    const int q0 = qb * 256, qmin = q0 + wid * 32, myq = qmin + r32;
    const size_t rowbase = (size_t)b * SEQ;
    constexpr int RS = 144, TILE = 64 * RS;
    LAS float* wsf = (LAS float*)(lds + 4 * TILE) + wid * 32;
    const LAS float* lut = (const LAS float*)(lds + LDS_LUT) + h * 129;
    bf16x8 qr[4];
    { const bf16* qp = P + (rowbase + myq) * PW + COL_QA + h * 64 + hi * 8;
#pragma unroll
      for (int d0 = 0; d0 < 4; ++d0) qr[d0] = *(const bf16x8*)(qp + d0 * 16); }
    const int NT = 4 * qb + 4;
    f32x16 o[2];
#pragma unroll
    for (int d = 0; d < 2; ++d)
#pragma unroll
        for (int i = 0; i < 16; ++i) o[d][i] = 0.f;
    float mrun = -INFINITY, lrun = 0.f;
    const float SC = 0.125f * LOG2E;
    const int lrow = tid >> 3, lc16 = tid & 7;
    const bf16* kg = P + (rowbase + lrow) * PW + COL_KA + h * 64 + lc16 * 8;
    const bf16* vg = P + (rowbase + lrow) * PW + COL_VA + h * 64 + lc16 * 8;
    u32x4 kr = *(const u32x4*)kg, vr = *(const u32x4*)vg;
    const u32x2* brow = (const u32x2*)(bits + (rowbase + myq) * 128);
    u32x2 wnext = brow[0];
    const int q4 = (lane & 15) >> 2;
    const int vcol = (16 * ((lane >> 4) & 1) + 4 * (lane & 3)) * 2;
    for (int t = 0; t < NT; ++t) {
        const int buf = t & 1;
        LAS unsigned char* Kb = lds + buf * TILE; LAS unsigned char* Vb = lds + (2 + buf) * TILE;
        *(LAS u32x4*)(Kb + lrow * RS + lc16 * 16) = kr; *(LAS u32x4*)(Vb + lrow * RS + lc16 * 16) = vr;
        __syncthreads();
        const u32x2 w = wnext;
        if (t + 1 < NT) { kr = *(const u32x4*)(kg + (size_t)(64 * (t + 1)) * PW); vr = *(const u32x4*)(vg + (size_t)(64 * (t + 1)) * PW); wnext = brow[t + 1]; }
        const int kb0 = 64 * t;
        if (kb0 > qmin + 31) continue;
        if (!__any((w.x | w.y) != 0u)) continue;
        f32x16 p0, p1;
#pragma unroll
        for (int i = 0; i < 16; ++i) { p0[i] = 0.f; p1[i] = 0.f; }
#pragma unroll
        for (int d0 = 0; d0 < 4; ++d0) {
            const bf16x8 a0 = *(const LAS bf16x8*)(Kb + r32 * RS + (d0 * 16 + hi * 8) * 2);
            const bf16x8 a1 = *(const LAS bf16x8*)(Kb + (32 + r32) * RS + (d0 * 16 + hi * 8) * 2);
            p0 = __builtin_amdgcn_mfma_f32_32x32x16_bf16(a0, qr[d0], p0, 0, 0, 0);
            p1 = __builtin_amdgcn_mfma_f32_32x32x16_bf16(a1, qr[d0], p1, 0, 0, 0);
        }
        const unsigned wl = w.x >> (4 * hi), wh = w.y >> (4 * hi);
        if (qmin - (kb0 + 63) >= 128) {
            const float c = lut[128];
#pragma unroll
            for (int i = 0; i < 16; ++i) { const unsigned bm = 1u << ((i & 3) + 8 * (i >> 2));
                p0[i] = (wl & bm) ? p0[i] * SC + c : -INFINITY; p1[i] = (wh & bm) ? p1[i] * SC + c : -INFINITY; }
        } else {
#pragma unroll
            for (int i = 0; i < 16; ++i) { const unsigned bm = 1u << ((i & 3) + 8 * (i >> 2));
                const int n0 = myq - (kb0 + crow(i, hi)), n1 = n0 - 32;
                const float b0 = lut[n0 < 0 ? 0 : (n0 > 128 ? 128 : n0)], b1 = lut[n1 < 0 ? 0 : (n1 > 128 ? 128 : n1)];
                p0[i] = (wl & bm) ? p0[i] * SC + b0 : -INFINITY; p1[i] = (wh & bm) ? p1[i] * SC + b1 : -INFINITY; }
        }
        float rm = fmaxf(p0[0], p1[0]);
#pragma unroll
        for (int i = 1; i < 16; ++i) rm = fmaxf(rm, fmaxf(p0[i], p1[i]));
        rm = fmaxf(rm, __shfl_xor(rm, 32));
        const float mnew = fmaxf(mrun, rm);
        const float msafe = (mnew == -INFINITY) ? 0.f : mnew;
        const float f = (mrun == -INFINITY) ? 1.0f : __builtin_amdgcn_exp2f(mrun - msafe);
        mrun = mnew;
        float ls = 0.f;
#pragma unroll
        for (int i = 0; i < 16; ++i) { p0[i] = __builtin_amdgcn_exp2f(p0[i] - msafe); p1[i] = __builtin_amdgcn_exp2f(p1[i] - msafe); ls += p0[i] + p1[i]; }
        lrun = lrun * f + ls;
        if (__any(f != 1.0f)) {
            if (hi == 0) wsf[r32] = f;
            __builtin_amdgcn_wave_barrier();
#pragma unroll
            for (int i = 0; i < 16; ++i) { const float fi = wsf[crow(i, hi)]; o[0][i] *= fi; o[1][i] *= fi; }
            __builtin_amdgcn_wave_barrier();
        }
        bf16x8 pa[4]; pa[0] = pack8(p0, 0); pa[1] = pack8(p0, 1); pa[2] = pack8(p1, 0); pa[3] = pack8(p1, 1);
#pragma unroll
        for (int d0 = 0; d0 < 2; ++d0)
#pragma unroll
            for (int ks = 0; ks < 4; ++ks) {
                const LAS unsigned char* vp = Vb + (16 * ks + 4 * hi + q4) * RS + d0 * 64 + vcol;
                const s16x4 lo = vtr(vp), hh = vtr(vp + 8 * RS);
                const bf16x8 vf = __builtin_shufflevector(lo, hh, 0, 1, 2, 3, 4, 5, 6, 7);
                o[d0] = __builtin_amdgcn_mfma_f32_32x32x16_bf16(pa[ks], vf, o[d0], 0, 0, 0);
            }
    }
    lrun += __shfl_xor(lrun, 32);
    if (hi == 0) wsf[r32] = 1.0f / lrun;
    __builtin_amdgcn_wave_barrier();
#pragma unroll
    for (int i = 0; i < 16; ++i) { const float fi = wsf[crow(i, hi)];
        bf16* orow = O + (rowbase + qmin + crow(i, hi)) * DM + h * 64 + r32;
        orow[0] = (bf16)f2bf(o[0][i] * fi); orow[32] = (bf16)f2bf(o[1][i] * fi); }
    __syncthreads();
}

__device__ __forceinline__ void att_phase(const Params& p, unsigned char* ldsg, int layer) {
    const int tid = launder_tid();
    const int j = layer >> 1;
    unsigned char* ws = p.ws;
    const bf16* P = (const bf16*)(ws + WS_PB); const bf16* IK = (const bf16*)(ws + WS_IK); bf16* O = (bf16*)(ws + WS_XB);
    float* scr = (float*)(ws + WS_SCR) + (size_t)blockIdx.x * 16 * SEQ;
    LAS float* lut = (LAS float*)((LAS unsigned char*)ldsg + LDS_LUT);
    LAS float* misc = lut + 12 * 129;
    const float* relb = p.in[5];
    for (int i = tid; i < 12 * 129; i += NTHREADS) { const int hd = i / 129, n = i % 129; lut[i] = relb[t5_bucket(n) * 12 + hd] * LOG2E; }
    if (tid < 64) {
        const float* lam = p.in[9] + (size_t)j * 4 * 64;
        const float a = wave_sum(lam[tid] * lam[64 + tid]), bb = wave_sum(lam[128 + tid] * lam[192 + tid]);
        if (tid == 0) misc[0] = a, misc[1] = bb;
    }
    __syncthreads();
    const float lam_init = 0.8f - 0.6f * expf(-0.3f * (float)layer);
    const float lam_full = expf(misc[0]) - expf(misc[1]) + lam_init;
    const float* subg = p.in[10] + (size_t)j * 128;
    for (int rep = 0; rep < DUP_DIFF; ++rep)
    for (int c = blockIdx.x; c < 256; c += gridDim.x) {
        const int b = c >> 7, h = (c >> 5) & 3, i = c & 31;
        if (EN_DIFF) diff_unit(ldsg, P, O, b, h, 63 - i, lam_full, 1.0f - lam_init, subg);
        if (EN_DIFF) diff_unit(ldsg, P, O, b, h, i, lam_full, 1.0f - lam_init, subg);
    }
    unsigned long long* bits = (unsigned long long*)(ws + WS_BITS);
    for (int rep = 0; rep < DUP_DSA; ++rep)
    for (int c = blockIdx.x; c < 256; c += gridDim.x) {
#pragma unroll 1
        for (int kq = 0; kq < 4; ++kq) {
            const int id = (kq == 0) ? 1023 - c : (kq == 1) ? 512 + c : (kq == 2) ? 511 - c : c;
            if (EN_DSA) dsa_unit(ldsg, P, IK, bits, scr, id & 1, (id >> 1) * 16);
        }
    }
}
__device__ __forceinline__ void attb_phase(const Params& p, unsigned char* ldsg) {
    const int tid = launder_tid();
    unsigned char* ws = p.ws;
    const bf16* P = (const bf16*)(ws + WS_PB); bf16* O = (bf16*)(ws + WS_XB);
    const unsigned long long* bits = (const unsigned long long*)(ws + WS_BITS);
    LAS float* lut = (LAS float*)((LAS unsigned char*)ldsg + LDS_LUT);
    const float* relb = p.in[5];
    for (int i = tid; i < 8 * 129; i += NTHREADS) { const int hd = i / 129, n = i % 129; lut[i] = relb[t5_bucket(n) * 12 + hd] * LOG2E; }
    __syncthreads();
    for (int rep = 0; rep < DUP_ATTB; ++rep)
    for (int c = blockIdx.x; c < 256; c += gridDim.x) {
        const int b = c >> 7, h = (c >> 4) & 7, i = c & 15;
        dsa_attn_unit(ldsg, P, bits, O, b, h, 31 - i);
        dsa_attn_unit(ldsg, P, bits, O, b, h, i);
    }
}

__global__ void __launch_bounds__(NTHREADS, 2) fwd_kernel(Params p) {
    extern __shared__ __attribute__((aligned(16))) unsigned char lds[];
    cg::grid_group grid = cg::this_grid();
    unsigned char* ws = p.ws;
    bf16* XB = (bf16*)(ws + WS_XB); bf16* PB = (bf16*)(ws + WS_PB); float* Y = (float*)(ws + WS_Y);
    for (int ph = p.ph_lo; ph < p.ph_hi; ++ph) {
        if (ph > p.ph_lo) grid.sync();
        if (ph == 0) { if (EN_PRO) prologue_phase(p, lds); continue; }
        int l, s;
        if (ph < 13) { l = 0; s = ph - 1; } else if (ph < 23) { l = 1; s = ph - 13; } else if (ph < 35) { l = 2; s = ph - 23; } else { l = 3; s = ph - 35; }
        if (l & 1) s = (s < 4) ? s : (s == 4) ? 5 : s + 2;
        const int j = l >> 1;
        const float* base = (ph <= 2) ? p.in[0] : p.out;
        if (s == 0 || s == 9) {
            const int f = (s == 9);
            pg8::Gemm g{XB, (const bf16*)(ws + WS_WFI + (size_t)(l * 2 + f) * SZ_WFI), MTOK, 5632, 1024}; pg8::StaticOrder S; S.init(MTOK, 5632, gridDim.x, blockIdx.x);
            pg8::EpiAct E{PB, DFF, 0};
            if (EN_GEMM1) pg8::gemm_phase<pg8::EpiAct, pg8::StaticOrder, true, true>((PG8_LAS unsigned char*)lds, g, S, E);
        } else if (s == 3 && (l & 1)) {
            pg8::Gemm g{XB, (const bf16*)(ws + WS_WCI + (size_t)j * SZ_WCI), MTOK, 2048, 1024}; pg8::StaticOrder S; S.init(MTOK, 2048, gridDim.x, blockIdx.x);
            pg8::EpiAct E{PB, DM, 1};
            if (EN_GEMM1) pg8::gemm_phase<pg8::EpiAct, pg8::StaticOrder, true, true>((PG8_LAS unsigned char*)lds, g, S, E);
        } else if (s == 1 || s == 10) {
            const int f = (s == 10);
            pg8::Gemm g{PB, (const bf16*)(ws + WS_WFO + (size_t)(l * 2 + f) * SZ_WFO), MTOK, DM, DFF}; pg8::StaticOrder S; S.init(MTOK, DM, gridDim.x, blockIdx.x);
            pg8::EpiRes E{base, Y, DM, ALPHA, 0.5f};
            if (EN_GEMM2) pg8::gemm_phase<pg8::EpiRes, pg8::StaticOrder, true, true>((PG8_LAS unsigned char*)lds, g, S, E);
        } else if (s == 7) {
            const bf16* Wt = (l & 1) ? (const bf16*)(ws + WS_WCO + (size_t)j * SZ_WCO) : (const bf16*)(ws + WS_WMO + (size_t)j * SZ_WMO);
            pg8::Gemm g{XB, Wt, MTOK, DM, DM}; pg8::StaticOrder S; S.init(MTOK, DM, gridDim.x, blockIdx.x);
            pg8::EpiRes E{base, Y, DM, ALPHA, 1.0f};
            if (EN_GEMM2) pg8::gemm_phase<pg8::EpiRes, pg8::StaticOrder, true, true>((PG8_LAS unsigned char*)lds, g, S, E);
        } else if (s == 3) {
            pg8::Gemm g{XB, (const bf16*)(ws + WS_WMI + (size_t)j * SZ_WMI), MTOK, PW, 1024}; pg8::StaticOrder S; S.init(MTOK, PW, gridDim.x, blockIdx.x);
            pg8::EpiBf16 E{PB, PW};
            if (EN_GEMM3) pg8::gemm_phase<pg8::EpiBf16, pg8::StaticOrder, true, true>((PG8_LAS unsigned char*)lds, g, S, E);
        } else if (s == 2 || s == 8 || s == 11) {
            const int which = (s == 2) ? 0 : (s == 8) ? 1 : 2;
            if (EN_LN) ln_phase(Y, p.in[3] + (size_t)(l * 3 + which) * DM, p.in[4] + (size_t)(l * 3 + which) * DM, p.out, XB);
        } else if (s == 4) {
            if (EN_IKLN) ikln_phase(PB, p.in[7] + (size_t)j * 64, p.in[8] + (size_t)j * 64, (bf16*)(ws + WS_IK));
        } else if (s == 5 && !(l & 1)) {
            att_phase(p, lds, l);
        } else if (s == 6) {
            attb_phase(p, lds);
        } else if (s == 5) {
            if (EN_CONV) conv_phase(PB, p.in[13] + (size_t)j * 31 * DM, p.in[14] + (size_t)j * DM, p.in[15] + (size_t)j * DM, p.in[16] + (size_t)j * DM, XB);
        }
    }
}
constexpr int NPHASES = 45;

#ifndef ONE_LAUNCH
#define ONE_LAUNCH 1
#endif
extern "C" void kernel_launch(void* const* d_in, const int* in_sizes, int n_in, void* d_out, int out_size, void* d_ws, size_t ws_size, hipStream_t stream) {
    static int grid = 0;
    if (grid == 0) {
        if (n_in != 18 || in_sizes[0] != MTOK * DM || out_size != MTOK * DM || ws_size < WS_END) { fprintf(stderr, "kernel_launch: unexpected shapes (n_in %d, in0 %d, out %d, ws %zu)\n", n_in, n_in > 0 ? in_sizes[0] : -1, out_size, ws_size); grid = -1; return; }
        int dev = 0, cus = 0, per_cu = 0;
        if (hipGetDevice(&dev) != hipSuccess || hipDeviceGetAttribute(&cus, hipDeviceAttributeMultiprocessorCount, dev) != hipSuccess) { grid = -1; return; }
        if (hipFuncSetAttribute((const void*)fwd_kernel, hipFuncAttributeMaxDynamicSharedMemorySize, LDS_BYTES) != hipSuccess) { fprintf(stderr, "kernel_launch: hipFuncSetAttribute failed\n"); grid = -1; return; }
        if (hipOccupancyMaxActiveBlocksPerMultiprocessor(&per_cu, (const void*)fwd_kernel, NTHREADS, LDS_BYTES) != hipSuccess || per_cu < 1) { fprintf(stderr, "kernel_launch: occupancy query gave %d\n", per_cu); per_cu = 1; }
        (void)hipGetLastError();
        grid = cus;
    }
    if (grid < 0) return;
    Params p{};
    for (int i = 0; i < 18; ++i) p.in[i] = (const float*)d_in[i];
    p.out = (float*)d_out; p.ws = (unsigned char*)d_ws;
#if ONE_LAUNCH
    p.ph_lo = 0; p.ph_hi = NPHASES;
    void* args[] = {&p};
    hipError_t e = hipLaunchCooperativeKernel((const void*)fwd_kernel, dim3(grid), dim3(NTHREADS), args, LDS_BYTES, stream);
    if (e != hipSuccess) fprintf(stderr, "cooperative launch failed: %s (grid %d)\n", hipGetErrorString(e), grid);
#else
    for (int ph = 0; ph < NPHASES; ++ph) { p.ph_lo = ph; p.ph_hi = ph + 1; hipLaunchKernelGGL(fwd_kernel, dim3(grid), dim3(NTHREADS), LDS_BYTES, stream, p); }
#endif
}
```

```cpp
#include <hip/hip_runtime.h>
#include <hip/hip_cooperative_groups.h>
#include <cstdio>
#include <cstdint>
#include <cmath>
namespace cg = cooperative_groups;
namespace pg8 {
#define PG8_LAS __attribute__((address_space(3)))
typedef unsigned short bf16_t;
typedef short bf16x8 __attribute__((ext_vector_type(8)));
typedef float f32x4 __attribute__((ext_vector_type(4)));
typedef unsigned u32x4 __attribute__((ext_vector_type(4)));
constexpr int BM = 256, BK = 64, HALF = 128, HTB = HALF * BK * 2  , STAGE_BYTES = 8 * HTB, NXCD = 8, WGM = 8;

__host__ __device__ __forceinline__ int lds_byte(int r, int c) { const int st = (r >> 4) * 2 + (c >> 5), rr = r & 15, cc = c & 31, ob = rr * 64 + cc * 2; return st * 1024 + (ob ^ (((ob >> 9) & 1) << 5)); }
__host__ __device__ __forceinline__ void stage_rc(int b, int& R, int& C) { const int st = b / 1024, sb = b % 1024, swz = sb ^ (((sb >> 9) & 1) << 5); R = (st >> 1) * 16 + swz / 64; C = (st & 1) * 32 + (swz % 64) / 2; }
__host__ __device__ __forceinline__ int perm32(int rho) { const int n = rho >> 4, i = rho & 15; return 8 * (i >> 2) + 4 * n + (i & 3); }

struct Unit { int pm, pn; };
struct Gemm { const bf16_t* A; const bf16_t* Bt; int M, N, K; };

struct StaticOrder {
    int nM, nN, nwg, G, c;
    __host__ __device__ void init(int M, int N, int G_, int c_) { nM = M / BM; nN = N / BM; nwg = nM * nN; G = G_; c = c_; }
    __host__ __device__ bool next(int i, Unit& u) const {
        const long L = (long)i * G + c; if (L >= nwg) return false;
        int wgid = (int)L; { const int q = nwg / NXCD, r = nwg % NXCD, xcd = wgid % NXCD, off = wgid / NXCD; wgid = (xcd < r ? xcd * (q + 1) : r * (q + 1) + (xcd - r) * q) + off; }
        const int nig = WGM * nN, gid = wgid / nig, fm = gid * WGM, gsz = (nM - fm) < WGM ? (nM - fm) : WGM;
        u.pm = fm + ((wgid % nig) % gsz); u.pn = (wgid % nig) / gsz; return true;
    }
    __device__ __forceinline__ void a_ready(const Unit&) const {}
    __device__ __forceinline__ void done(const Unit&) const {}
};

__device__ __forceinline__ unsigned cvt_pk_bf16(float lo, float hi) { unsigned r; asm volatile("v_cvt_pk_bf16_f32 %0, %1, %2" : "=v"(r) : "v"(lo), "v"(hi)); return r; }
typedef float f32x2 __attribute__((ext_vector_type(2)));
typedef unsigned u32x4 __attribute__((ext_vector_type(4)));
__device__ __forceinline__ float sigmoidf_fast(float x) { return __builtin_amdgcn_rcpf(1.0f + __builtin_amdgcn_exp2f(-1.4426950408889634f * x)); }
struct EpiBf16 {
    static constexpr bool PERM = true, AFTER_DRAIN = false;
    bf16_t* O; int ldc;
    __device__ __forceinline__ void operator()(const f32x4 (&acc)[2][2][4][2], const Unit& u, int wr, int wc, int fr, int fq) const {
        const int row0 = u.pm * BM + wr * 64 + fr; const int col0 = u.pn * BM + wc * 32 + 8 * fq;
#pragma unroll
        for (int ai = 0; ai < 2; ++ai)
#pragma unroll
            for (int m = 0; m < 4; ++m) { bf16_t* rowp = O + (size_t)(row0 + ai * HALF + m * 16) * ldc + col0;
#pragma unroll
                for (int bj = 0; bj < 2; ++bj) { const f32x4 v0 = acc[ai][bj][m][0], v1 = acc[ai][bj][m][1];
                    u32x4 w; w.x = cvt_pk_bf16(v0[0], v0[1]); w.y = cvt_pk_bf16(v0[2], v0[3]); w.z = cvt_pk_bf16(v1[0], v1[1]); w.w = cvt_pk_bf16(v1[2], v1[3]);
                    *(u32x4*)(rowp + bj * HALF) = w; } }
    }
};
struct EpiAct {
    static constexpr bool PERM = true, AFTER_DRAIN = false;
    bf16_t* O; int ldc; int mode;
    __device__ __forceinline__ void operator()(const f32x4 (&acc)[2][2][4][2], const Unit& u, int wr, int wc, int fr, int fq) const {
        const int row0 = u.pm * BM + wr * 64 + fr; const int col0 = u.pn * HALF + wc * 32 + 8 * fq;
#pragma unroll
        for (int ai = 0; ai < 2; ++ai)
#pragma unroll
            for (int m = 0; m < 4; ++m) { bf16_t* rowp = O + (size_t)(row0 + ai * HALF + m * 16) * ldc + col0;
                float r[8];
#pragma unroll
                for (int n = 0; n < 2; ++n)
#pragma unroll
                    for (int e = 0; e < 4; ++e) { const float a = acc[ai][0][m][n][e], b = acc[ai][1][m][n][e];
                        const float s = sigmoidf_fast(mode ? b : a); r[4 * n + e] = mode ? a * s : a * s * b; }
                u32x4 w; w.x = cvt_pk_bf16(r[0], r[1]); w.y = cvt_pk_bf16(r[2], r[3]); w.z = cvt_pk_bf16(r[4], r[5]); w.w = cvt_pk_bf16(r[6], r[7]);
                *(u32x4*)rowp = w; }
    }
};
struct EpiRes {
    static constexpr bool PERM = false, AFTER_DRAIN = false;
    const float* base; float* out; int ldc; float alpha, scale;
    __device__ __forceinline__ void operator()(const f32x4 (&acc)[2][2][4][2], const Unit& u, int wr, int wc, int fr, int fq) const {
        const int col0 = u.pn * BM + wc * 32 + 4 * fq;
#pragma unroll
        for (int ai = 0; ai < 2; ++ai)
#pragma unroll
            for (int m = 0; m < 4; ++m) { const int r = u.pm * BM + ai * HALF + wr * 64 + m * 16 + fr; const size_t off = (size_t)r * ldc + col0;
#pragma unroll
                for (int bj = 0; bj < 2; ++bj)
#pragma unroll
                    for (int n = 0; n < 2; ++n) { const f32x4 bs = *(const f32x4*)(base + off + bj * HALF + n * 16);
                        *(f32x4*)(out + off + bj * HALF + n * 16) = bs * alpha + acc[ai][bj][m][n] * scale; } }
    }
};
template <class Epi, class Sched, bool ALIGN_EPI = false, bool SP2 = false>
__device__ __forceinline__ void gemm_phase(PG8_LAS unsigned char* lds, const Gemm g, const Sched& S, const Epi& E) {
    int tid_ = threadIdx.x; asm volatile("" : "+v"(tid_));
    const int tid = tid_, wid = __builtin_amdgcn_readfirstlane(tid >> 6), lane = tid & 63, wr = wid >> 2, wc = wid & 3, fr = lane & 15, fq = lane >> 4;
    const int K = g.K, nt = K / BK;
    unsigned voffA[2], voffB[2];
#pragma unroll
    for (int i = 0; i < 2; ++i) { int R, C; stage_rc(tid * 16 + i * 8192, R, C); const int Rb = Epi::PERM ? ((R & ~31) + perm32(R & 31)) : R;
        voffA[i] = (unsigned)(R * K + C) * 2u; voffB[i] = (unsigned)(Rb * K + C) * 2u; }
    const size_t kstep = (size_t)(BK * 2);
    const size_t hstep = (size_t)HALF * K * 2;
    const size_t tstep = 2 * hstep;
    const unsigned ldsw = (unsigned)wid * 1024u;
    const int aoff = lds_byte(wr * 64 + fr, fq * 8), boff = lds_byte(wc * 32 + fr, fq * 8);
#define PG8_SA(b, h) (((b) * 2 + (h)) * HTB)
#define PG8_SB(b, h) ((4 + (b) * 2 + (h)) * HTB)
#define PG8_STAGE(bufoff, gbase, voff) do { _Pragma("unroll") for (int _i = 0; _i < 2; ++_i) \
        __builtin_amdgcn_global_load_lds((const unsigned*)((const char*)(gbase) + (voff)[_i]), (PG8_LAS unsigned*)(lds + (bufoff) + ldsw + _i * 8192), 16, 0, 0); } while (0)
#define PG8_LDA(dst, b, h) do { _Pragma("unroll") for (int m = 0; m < 4; ++m) _Pragma("unroll") for (int k = 0; k < 2; ++k) dst[m][k] = *(const PG8_LAS bf16x8*)(lds + PG8_SA(b, h) + aoff + m * 2048 + k * 1024); } while (0)
#define PG8_LDB(dst, b, h) do { _Pragma("unroll") for (int n = 0; n < 2; ++n) _Pragma("unroll") for (int k = 0; k < 2; ++k) dst[n][k] = *(const PG8_LAS bf16x8*)(lds + PG8_SB(b, h) + boff + n * 2048 + k * 1024); } while (0)
#define PG8_MMA(ai, bj, At, Bt) do { __builtin_amdgcn_s_setprio(1); _Pragma("unroll") for (int m = 0; m < 4; ++m) _Pragma("unroll") for (int n = 0; n < 2; ++n) _Pragma("unroll") for (int k = 0; k < 2; ++k) \
        acc[ai][bj][m][n] = __builtin_amdgcn_mfma_f32_16x16x32_bf16(Bt[n][k], At[m][k], acc[ai][bj][m][n], 0, 0, 0); __builtin_amdgcn_s_setprio(0); } while (0)
#define PG8_WAIT_V(n) asm volatile("s_waitcnt vmcnt(" #n ")" ::: "memory")
#define PG8_WAIT_L(n) asm volatile("s_waitcnt lgkmcnt(" #n ")" ::: "memory")
#define PG8_BAR __builtin_amdgcn_s_barrier()
#define PG8_SCHED __builtin_amdgcn_sched_barrier(0)
    Unit cur, nxt; int ui = 0;
    if (!S.next(0, cur)) return;
    f32x4 acc[2][2][4][2];
#pragma unroll
    for (int a = 0; a < 2; ++a)
#pragma unroll
        for (int b = 0; b < 2; ++b)
#pragma unroll
            for (int m = 0; m < 4; ++m)
#pragma unroll
                for (int n = 0; n < 2; ++n) acc[a][b][m][n] = (f32x4){0.f, 0.f, 0.f, 0.f};
    bf16x8 At[4][2], B0[2][2], B1[2][2];
    const char* cA = (const char*)g.A + (size_t)cur.pm * tstep; const char* cB = (const char*)g.Bt + (size_t)cur.pn * tstep;
    S.a_ready(cur);
    if constexpr (SP2) {
        PG8_STAGE(PG8_SB(0, 0), cB, voffB); PG8_STAGE(PG8_SB(0, 1), cB + hstep, voffB); PG8_STAGE(PG8_SA(0, 0), cA, voffA); PG8_STAGE(PG8_SA(0, 1), cA + hstep, voffA);
        if (wr == 1) PG8_BAR;
        PG8_WAIT_V(2); PG8_BAR;
        PG8_STAGE(PG8_SB(1, 0), cB + kstep, voffB); PG8_STAGE(PG8_SA(1, 0), cA + kstep, voffA); PG8_STAGE(PG8_SB(1, 1), cB + hstep + kstep, voffB);
        PG8_WAIT_V(6); PG8_BAR;
    } else {
        PG8_STAGE(PG8_SB(0, 0), cB, voffB); PG8_STAGE(PG8_SA(0, 0), cA, voffA); PG8_STAGE(PG8_SB(0, 1), cB + hstep, voffB); PG8_STAGE(PG8_SA(0, 1), cA + hstep, voffA);
        if (wr == 1) PG8_BAR;
        PG8_WAIT_V(4); PG8_BAR;
        PG8_STAGE(PG8_SB(1, 0), cB + kstep, voffB); PG8_STAGE(PG8_SA(1, 0), cA + kstep, voffA); PG8_STAGE(PG8_SB(1, 1), cB + hstep + kstep, voffB);
        PG8_WAIT_V(6); PG8_BAR;
    }
    for (;;) {
        const bool has_next = S.next(ui + 1, nxt);
        const char* nA = has_next ? (const char*)g.A + (size_t)nxt.pm * tstep : cA; const char* nB = has_next ? (const char*)g.Bt + (size_t)nxt.pn * tstep : cB;
        for (int t = 0; t < nt; t += 2) {
            const bool last = (t == nt - 2);
            const char* a1 = cA + (size_t)(t + 1) * kstep;
            const char* a2 = last ? nA : cA + (size_t)(t + 2) * kstep; const char* b2 = last ? nB : cB + (size_t)(t + 2) * kstep;
            const char* a3 = a2 + kstep; const char* b3 = b2 + kstep;
            if (last && has_next) S.a_ready(nxt);
            if constexpr (SP2) {
            PG8_LDB(B0, 0, 0); PG8_LDB(B1, 0, 1); PG8_SCHED; PG8_LDA(At, 0, 0); PG8_STAGE(PG8_SA(1, 1), a1 + hstep, voffA);
            PG8_WAIT_V(8); PG8_WAIT_L(0); PG8_BAR; PG8_MMA(0, 0, At, B0); PG8_MMA(0, 1, At, B1); PG8_BAR; PG8_SCHED;
            PG8_LDA(At, 0, 1); PG8_STAGE(PG8_SB(0, 0), b2, voffB); PG8_STAGE(PG8_SB(0, 1), b2 + hstep, voffB); PG8_STAGE(PG8_SA(0, 0), a2, voffA);
            PG8_WAIT_V(8); PG8_WAIT_L(0); PG8_BAR; PG8_MMA(1, 0, At, B0); PG8_MMA(1, 1, At, B1); PG8_BAR; PG8_SCHED;
            PG8_LDB(B0, 1, 0); PG8_LDB(B1, 1, 1); PG8_SCHED; PG8_LDA(At, 1, 0); PG8_STAGE(PG8_SA(0, 1), a2 + hstep, voffA);
            PG8_WAIT_V(8); PG8_WAIT_L(0); PG8_BAR; PG8_MMA(0, 0, At, B0); PG8_MMA(0, 1, At, B1); PG8_BAR; PG8_SCHED;
            PG8_LDA(At, 1, 1); PG8_STAGE(PG8_SB(1, 0), b3, voffB); PG8_STAGE(PG8_SB(1, 1), b3 + hstep, voffB); PG8_STAGE(PG8_SA(1, 0), a3, voffA);
            PG8_WAIT_V(8); PG8_WAIT_L(0); PG8_BAR; PG8_MMA(1, 0, At, B0); PG8_MMA(1, 1, At, B1); PG8_BAR; PG8_SCHED;
            } else {
            PG8_LDB(B0, 0, 0); PG8_SCHED; PG8_LDA(At, 0, 0); PG8_STAGE(PG8_SA(1, 1), a1 + hstep, voffA);
            PG8_WAIT_L(8); PG8_BAR; PG8_WAIT_L(0); PG8_MMA(0, 0, At, B0); PG8_BAR; PG8_SCHED;
            PG8_LDB(B1, 0, 1); PG8_STAGE(PG8_SB(0, 0), b2, voffB);
            PG8_BAR; PG8_WAIT_L(0); PG8_MMA(0, 1, At, B1); PG8_BAR;
            PG8_LDA(At, 0, 1); PG8_STAGE(PG8_SA(0, 0), a2, voffA);
            PG8_BAR; PG8_WAIT_L(0); PG8_MMA(1, 0, At, B0); PG8_BAR; PG8_SCHED;
            PG8_STAGE(PG8_SB(0, 1), b2 + hstep, voffB);
            PG8_WAIT_V(6); PG8_BAR; PG8_MMA(1, 1, At, B1); PG8_BAR;
            PG8_LDB(B0, 1, 0); PG8_SCHED; PG8_LDA(At, 1, 0); PG8_STAGE(PG8_SA(0, 1), a2 + hstep, voffA);
            PG8_WAIT_L(8); PG8_BAR; PG8_WAIT_L(0); PG8_MMA(0, 0, At, B0); PG8_BAR; PG8_SCHED;
            PG8_LDB(B1, 1, 1); PG8_STAGE(PG8_SB(1, 0), b3, voffB);
            PG8_BAR; PG8_WAIT_L(0); PG8_MMA(0, 1, At, B1); PG8_BAR;
            PG8_LDA(At, 1, 1); PG8_STAGE(PG8_SA(1, 0), a3, voffA);
            PG8_BAR; PG8_WAIT_L(0); PG8_MMA(1, 0, At, B0); PG8_BAR; PG8_SCHED;
            PG8_STAGE(PG8_SB(1, 1), b3 + hstep, voffB);
            PG8_WAIT_V(6); PG8_BAR; PG8_MMA(1, 1, At, B1); PG8_BAR;
            }
        }
        if constexpr (ALIGN_EPI) { if (wr == 0) PG8_BAR; }
        if constexpr (!Epi::AFTER_DRAIN) { E(acc, cur, wr, wc, fr, fq); S.done(cur); }
        if (!has_next) break;
#pragma unroll
        for (int a = 0; a < 2; ++a)
#pragma unroll
            for (int b = 0; b < 2; ++b)
#pragma unroll
                for (int m = 0; m < 4; ++m)
#pragma unroll
                    for (int n = 0; n < 2; ++n) acc[a][b][m][n] = (f32x4){0.f, 0.f, 0.f, 0.f};
        cur = nxt; cA = nA; cB = nB; ++ui;
        if constexpr (ALIGN_EPI) { if (wr == 1) PG8_BAR; }
    }
    PG8_WAIT_V(0);
    if constexpr (!ALIGN_EPI) { if (wr == 0) PG8_BAR; }
    PG8_BAR;
    if constexpr (Epi::AFTER_DRAIN) { E.fused(acc, cur, wr, wc, fr, fq, lds, wid, lane); S.done(cur); }
#undef PG8_SA
#undef PG8_SB
#undef PG8_STAGE
#undef PG8_LDA
#undef PG8_LDB
#undef PG8_MMA
#undef PG8_WAIT_V
#undef PG8_WAIT_L
#undef PG8_BAR
#undef PG8_SCHED
}
}
#ifndef DUP_DIFF
#define DUP_DIFF 1
#endif
#ifndef DUP_DSA
#define DUP_DSA 1
#endif
#ifndef DUP_ATTB
#define DUP_ATTB 1
#endif
#ifndef DUP_PH
#define DUP_PH 0
#endif
#ifndef DUP_SYNC
#define DUP_SYNC 0
#endif
#ifndef DUP_PRO
#define DUP_PRO 1
#endif
#ifndef DUP_CONV
#define DUP_CONV 1
#endif
#ifndef EN_MASK
#define EN_MASK 0xffff
#endif
#define EN_PRO ((EN_MASK) & 1)
#define EN_GEMM1 ((EN_MASK) & 2)
#define EN_GEMM2 ((EN_MASK) & 4)
#define EN_GEMM3 ((EN_MASK) & 8)
#define EN_LN ((EN_MASK) & 16)
#define EN_IKLN ((EN_MASK) & 32)
#define EN_CONV ((EN_MASK) & 64)
#define EN_DIFF ((EN_MASK) & 128)
#define EN_DSA ((EN_MASK) & 256)
constexpr int SEQ = 8192, NB = 2, MTOK = NB * SEQ, DM = 1024, DFF = 2816, DEPTH = 4;
constexpr int PW = 3840;
constexpr int COL_QA = 0, COL_KA = 512, COL_VA = 1024, COL_IQ = 1536, COL_QB = 2048, COL_KB = 2560, COL_VB = 3072, COL_IK = 3584, COL_IW = 3648;
constexpr int PMIX = 3656;
constexpr float LN_EPS = 1e-5f;
constexpr float ALPHA = 1.6817928305074290f;
constexpr float LOG2E = 1.4426950408889634f;
constexpr int NTHREADS = 512, NWAVES = 8;
constexpr size_t MiB = 1u << 20;
constexpr size_t WS_WFI = 0, SZ_WFI = 11 * MiB;
constexpr size_t WS_WFO = 88 * MiB, SZ_WFO = 5632 * 1024;
constexpr size_t WS_WMI = 132 * MiB, SZ_WMI = (size_t)PW * 1024 * 2;
constexpr size_t WS_WMO = 147 * MiB, SZ_WMO = 2 * MiB;
constexpr size_t WS_WCI = 151 * MiB, SZ_WCI = 4 * MiB;
constexpr size_t WS_WCO = 159 * MiB, SZ_WCO = 2 * MiB;
constexpr size_t WS_XB = 164 * MiB;
constexpr size_t WS_PB = 196 * MiB;
constexpr size_t WS_Y = 316 * MiB;
constexpr size_t WS_SCR = 380 * MiB;
constexpr size_t WS_IK = 508 * MiB;
constexpr size_t WS_BITS = 510 * MiB;
constexpr size_t WS_CTL = 526 * MiB, CTL_BYTES = 65536;
constexpr size_t WS_END = 527 * MiB;
constexpr int LDS_BYTES = 131072 + 8192;
constexpr int LDS_LUT = 131072;

typedef unsigned short bf16;
typedef short bf16x8 __attribute__((ext_vector_type(8)));
typedef short s16x4 __attribute__((ext_vector_type(4)));
typedef float f32x4 __attribute__((ext_vector_type(4)));
typedef float f32x16 __attribute__((ext_vector_type(16)));
typedef unsigned u32x4 __attribute__((ext_vector_type(4)));
typedef unsigned u32x2 __attribute__((ext_vector_type(2)));
#define LAS __attribute__((address_space(3)))

__device__ __forceinline__ unsigned f2bf(float f) { unsigned u = __builtin_bit_cast(unsigned, f); return (u + 0x7fffu + ((u >> 16) & 1u)) >> 16; }
__device__ __forceinline__ unsigned pk2(float lo, float hi) { return f2bf(lo) | (f2bf(hi) << 16); }
__device__ __forceinline__ float bflo(unsigned w) { return __builtin_bit_cast(float, w << 16); }
__device__ __forceinline__ float bfhi(unsigned w) { return __builtin_bit_cast(float, w & 0xffff0000u); }
__device__ __forceinline__ float wave_sum(float v) {
#pragma unroll
    for (int o = 1; o < 64; o <<= 1) v += __shfl_xor(v, o);
    return v;
}
__device__ __forceinline__ int launder_tid() { int t = threadIdx.x; asm volatile("" : "+v"(t)); return t; }
__device__ __forceinline__ int wave_sum_i(int v) {
#pragma unroll
    for (int o = 1; o < 64; o <<= 1) v += __shfl_xor(v, o);
    return v;
}
__device__ __forceinline__ int crow(int r, int hi) { return (r & 3) + 8 * (r >> 2) + 4 * hi; }

struct Params { const float* in[18]; float* out; unsigned char* ws; int ph_lo, ph_hi; };

__device__ __forceinline__ int dest_row(int n, int mode, int NH) {
    if (mode == 0) return n;
    if (mode == 1) { const int hf = n >= NH ? 1 : 0, nn = n - hf * NH; return (nn >> 7) * 256 + hf * 128 + (nn & 127); }
    if (n < 2048) return n;
    if (n < 2112) return COL_IK + (n - 2048);
    if (n < 2120) return COL_IW + (n - 2112);
    return COL_QB + (n - 2120);
}
__device__ __forceinline__ void transpose_item(const float* W, int K, int N, bf16* WT, int mode, LAS float* scr, int item, int lane) {
    const int nblk = (N + 31) / 32, kb = item / nblk, nb = item % nblk, k0 = 64 * kb, n0 = 32 * nb;
    const int nr = n0 + (lane & 31);
#pragma unroll 8
    for (int i = 0; i < 32; ++i) { const int kk = 2 * i + (lane >> 5); scr[kk * 33 + (lane & 31)] = nr < N ? W[(size_t)(k0 + kk) * N + nr] : 0.f; }
    asm volatile("s_waitcnt lgkmcnt(0)" ::: "memory");
    const int c = lane & 7;
#pragma unroll
    for (int j = 0; j < 4; ++j) { const int n = (lane >> 3) + 8 * j; const LAS float* s = scr + (8 * c) * 33 + n;
        u32x4 o; o.x = pk2(s[0 * 33], s[1 * 33]); o.y = pk2(s[2 * 33], s[3 * 33]); o.z = pk2(s[4 * 33], s[5 * 33]); o.w = pk2(s[6 * 33], s[7 * 33]);
        if (n0 + n < N) *(u32x4*)(WT + (size_t)dest_row(n0 + n, mode, N / 2) * K + k0 + 8 * c) = o; }
    asm volatile("s_waitcnt lgkmcnt(0)" ::: "memory");
}
__device__ __forceinline__ void prologue_phase(const Params& p, unsigned char* lds) {
    const int tid = launder_tid(), lane = tid & 63, wave = __builtin_amdgcn_readfirstlane(tid >> 6);
    LAS float* scr = (LAS float*)((LAS unsigned char*)lds + wave * 16384);
    const int gw = blockIdx.x * NWAVES + wave, NGW = gridDim.x * NWAVES;
    unsigned char* ws = p.ws;
    constexpr int I_FI = (1024 / 64) * (5632 / 32), I_FO = (2816 / 64) * (1024 / 32), I_MI = (1024 / 64) * ((PMIX + 31) / 32), I_SQ = (1024 / 64) * (1024 / 32), I_CI = (1024 / 64) * (2048 / 32);
    constexpr int T_FI = 8 * I_FI, T_FO = 8 * I_FO, T_MI = 2 * I_MI, T_MO = 2 * I_SQ, T_CI = 2 * I_CI, T_CO = 2 * I_SQ;
    constexpr int NITEMS = T_FI + T_FO + T_MI + T_MO + T_CI + T_CO;
    for (int it = gw; it < NITEMS; it += NGW) {
        int r = it;
        if (r < T_FI) { const int w = r / I_FI; transpose_item(p.in[1] + (size_t)w * 1024 * 5632, 1024, 5632, (bf16*)(ws + WS_WFI + w * SZ_WFI), 1, scr, r % I_FI, lane); continue; } r -= T_FI;
        if (r < T_FO) { const int w = r / I_FO; transpose_item(p.in[2] + (size_t)w * 2816 * 1024, 2816, 1024, (bf16*)(ws + WS_WFO + w * SZ_WFO), 0, scr, r % I_FO, lane); continue; } r -= T_FO;
        if (r < T_MI) { const int w = r / I_MI; transpose_item(p.in[6] + (size_t)w * 1024 * PMIX, 1024, PMIX, (bf16*)(ws + WS_WMI + w * SZ_WMI), 2, scr, r % I_MI, lane); continue; } r -= T_MI;
        if (r < T_MO) { const int w = r / I_SQ; transpose_item(p.in[11] + (size_t)w * 1024 * 1024, 1024, 1024, (bf16*)(ws + WS_WMO + w * SZ_WMO), 0, scr, r % I_SQ, lane); continue; } r -= T_MO;
        if (r < T_CI) { const int w = r / I_CI; transpose_item(p.in[12] + (size_t)w * 1024 * 2048, 1024, 2048, (bf16*)(ws + WS_WCI + w * SZ_WCI), 1, scr, r % I_CI, lane); continue; } r -= T_CI;
        { const int w = r / I_SQ; transpose_item(p.in[17] + (size_t)w * 1024 * 1024, 1024, 1024, (bf16*)(ws + WS_WCO + w * SZ_WCO), 0, scr, r % I_SQ, lane); }
    }
    const float* x = p.in[0]; bf16* xb = (bf16*)(ws + WS_XB);
    for (int m = gw; m < MTOK; m += NGW) {
        const f32x4* xr = (const f32x4*)(x + (size_t)m * DM) + lane; u32x2* o = (u32x2*)(xb + (size_t)m * DM) + lane;
#pragma unroll
        for (int j = 0; j < 4; ++j) { const f32x4 v = xr[64 * j]; u32x2 w; w.x = pk2(v.x, v.y); w.y = pk2(v.z, v.w); o[64 * j] = w; }
    }
}
__device__ __forceinline__ void ln_phase(const float* Y, const float* g, const float* bta, float* X, bf16* XB) {
    const int tid = launder_tid(), lane = tid & 63, wave = __builtin_amdgcn_readfirstlane(tid >> 6);
    const int gw = blockIdx.x * NWAVES + wave, NGW = gridDim.x * NWAVES;
    f32x4 gv[4], bv[4];
#pragma unroll
    for (int j = 0; j < 4; ++j) { gv[j] = ((const f32x4*)g)[lane + 64 * j]; bv[j] = ((const f32x4*)bta)[lane + 64 * j]; }
    for (int m = gw; m < MTOK; m += NGW) {
        const f32x4* yr = (const f32x4*)(Y + (size_t)m * DM) + lane;
        f32x4 v[4]; float s = 0.f;
#pragma unroll
        for (int j = 0; j < 4; ++j) { v[j] = yr[64 * j]; s += (v[j].x + v[j].y) + (v[j].z + v[j].w); }
        const float mean = wave_sum(s) * (1.f / DM); float s2 = 0.f;
#pragma unroll
        for (int j = 0; j < 4; ++j) { v[j] = v[j] - mean; s2 += (v[j].x * v[j].x + v[j].y * v[j].y) + (v[j].z * v[j].z + v[j].w * v[j].w); }
        const float rstd = 1.0f / sqrtf(wave_sum(s2) * (1.f / DM) + LN_EPS);
        f32x4* xo = (f32x4*)(X + (size_t)m * DM) + lane; u32x2* bo = (u32x2*)(XB + (size_t)m * DM) + lane;
#pragma unroll
        for (int j = 0; j < 4; ++j) { const f32x4 o = v[j] * rstd * gv[j] + bv[j]; xo[64 * j] = o; u32x2 w; w.x = pk2(o.x, o.y); w.y = pk2(o.z, o.w); bo[64 * j] = w; }
    }
}
__device__ __forceinline__ void ikln_phase(const bf16* P, const float* g, const float* bta, bf16* IK) {
    const int gt = blockIdx.x * NTHREADS + launder_tid(), NT = gridDim.x * NTHREADS;
    for (int m = gt; m < MTOK; m += NT) {
        const u32x4* src = (const u32x4*)(P + (size_t)m * PW + COL_IK);
        float v[64]; float s = 0.f;
#pragma unroll
        for (int c = 0; c < 8; ++c) { const u32x4 w = src[c];
            v[8 * c + 0] = bflo(w.x); v[8 * c + 1] = bfhi(w.x); v[8 * c + 2] = bflo(w.y); v[8 * c + 3] = bfhi(w.y);
            v[8 * c + 4] = bflo(w.z); v[8 * c + 5] = bfhi(w.z); v[8 * c + 6] = bflo(w.w); v[8 * c + 7] = bfhi(w.w); }
#pragma unroll
        for (int i = 0; i < 64; ++i) s += v[i];
        const float mean = s * (1.f / 64.f); float s2 = 0.f;
#pragma unroll
        for (int i = 0; i < 64; ++i) { v[i] -= mean; s2 += v[i] * v[i]; }
        const float rstd = 1.0f / sqrtf(s2 * (1.f / 64.f) + LN_EPS);
        u32x4* dst = (u32x4*)(IK + (size_t)m * 64);
#pragma unroll
        for (int c = 0; c < 8; ++c) { u32x4 w;
            w.x = pk2(v[8 * c + 0] * rstd * g[8 * c + 0] + bta[8 * c + 0], v[8 * c + 1] * rstd * g[8 * c + 1] + bta[8 * c + 1]);
            w.y = pk2(v[8 * c + 2] * rstd * g[8 * c + 2] + bta[8 * c + 2], v[8 * c + 3] * rstd * g[8 * c + 3] + bta[8 * c + 3]);
            w.z = pk2(v[8 * c + 4] * rstd * g[8 * c + 4] + bta[8 * c + 4], v[8 * c + 5] * rstd * g[8 * c + 5] + bta[8 * c + 5]);
            w.w = pk2(v[8 * c + 6] * rstd * g[8 * c + 6] + bta[8 * c + 6], v[8 * c + 7] * rstd * g[8 * c + 7] + bta[8 * c + 7]);
            dst[c] = w; }
    }
}
__device__ __forceinline__ void conv_phase(const bf16* U, const float* dw, const float* dwb, const float* g, const float* bta, bf16* V) {
    const int tid = launder_tid(), lane = tid & 63, wave = __builtin_amdgcn_readfirstlane(tid >> 6);
    const int gw = blockIdx.x * NWAVES + wave, NGW = gridDim.x * NWAVES;
    for (int m = gw; m < MTOK; m += NGW) {
        const int t = m & (SEQ - 1);
        float acc[16];
#pragma unroll
        for (int jj = 0; jj < 2; ++jj) { const int c0 = lane * 8 + 512 * jj; const f32x4 b0 = *(const f32x4*)(dwb + c0), b1 = *(const f32x4*)(dwb + c0 + 4);
            acc[8 * jj + 0] = b0.x; acc[8 * jj + 1] = b0.y; acc[8 * jj + 2] = b0.z; acc[8 * jj + 3] = b0.w; acc[8 * jj + 4] = b1.x; acc[8 * jj + 5] = b1.y; acc[8 * jj + 6] = b1.z; acc[8 * jj + 7] = b1.w; }
        const int j0 = t >= 30 ? 0 : 30 - t;
        for (int j = j0; j < 31; ++j) {
            const bf16* urow = U + (size_t)(m - 30 + j) * DM; const float* wrow = dw + (size_t)j * DM;
#pragma unroll
            for (int jj = 0; jj < 2; ++jj) { const int c0 = lane * 8 + 512 * jj; const u32x4 u = *(const u32x4*)(urow + c0); const f32x4 w0 = *(const f32x4*)(wrow + c0), w1 = *(const f32x4*)(wrow + c0 + 4);
                acc[8 * jj + 0] += bflo(u.x) * w0.x; acc[8 * jj + 1] += bfhi(u.x) * w0.y; acc[8 * jj + 2] += bflo(u.y) * w0.z; acc[8 * jj + 3] += bfhi(u.y) * w0.w;
                acc[8 * jj + 4] += bflo(u.z) * w1.x; acc[8 * jj + 5] += bfhi(u.z) * w1.y; acc[8 * jj + 6] += bflo(u.w) * w1.z; acc[8 * jj + 7] += bfhi(u.w) * w1.w; }
        }
        float s = 0.f;
#pragma unroll
        for (int i = 0; i < 16; ++i) s += acc[i];
        const float mean = wave_sum(s) * (1.f / DM); float s2 = 0.f;
#pragma unroll
        for (int i = 0; i < 16; ++i) { acc[i] -= mean; s2 += acc[i] * acc[i]; }
        const float rstd = 1.0f / sqrtf(wave_sum(s2) * (1.f / DM) + LN_EPS);
#pragma unroll
        for (int jj = 0; jj < 2; ++jj) { const int c0 = lane * 8 + 512 * jj; float o[8];
#pragma unroll
            for (int e = 0; e < 8; ++e) { const float y = acc[8 * jj + e] * rstd * g[c0 + e] + bta[c0 + e]; o[e] = y * pg8::sigmoidf_fast(y); }
            u32x4 w; w.x = pk2(o[0], o[1]); w.y = pk2(o[2], o[3]); w.z = pk2(o[4], o[5]); w.w = pk2(o[6], o[7]);
            *(u32x4*)(V + (size_t)m * DM + c0) = w; }
    }
}
__device__ __forceinline__ int t5_bucket(int n) {
    if (n < 16) return n;
    int v = 16 + (int)(logf((float)n / 16.0f) / logf(8.0f) * 16.0f);
    return v < 31 ? v : 31;
}
__device__ __forceinline__ unsigned cvtpk(float lo, float hi) { typedef float f2 __attribute__((ext_vector_type(2))); typedef __bf16 b2 __attribute__((ext_vector_type(2))); f2 v = {lo, hi}; b2 b = __builtin_convertvector(v, b2); return __builtin_bit_cast(unsigned, b); }
__device__ __forceinline__ bf16x8 pack8(const f32x16& x, int s) {
    u32x4 p; p.x = cvtpk(x[8 * s + 0], x[8 * s + 1]); p.y = cvtpk(x[8 * s + 2], x[8 * s + 3]); p.z = cvtpk(x[8 * s + 4], x[8 * s + 5]); p.w = cvtpk(x[8 * s + 6], x[8 * s + 7]);
    return __builtin_bit_cast(bf16x8, p);
}
typedef short v4i16_t __attribute__((ext_vector_type(4)));
__device__ __forceinline__ s16x4 vtr(const LAS unsigned char* p) { return __builtin_bit_cast(s16x4, __builtin_amdgcn_ds_read_tr16_b64_v4i16((LAS v4i16_t*)p)); }

__device__ __forceinline__ void diff_unit(unsigned char* ldsg, const bf16* P, bf16* O, int b, int h, int qb, float lam_full, float oscale, const float* subg) {
    LAS unsigned char* lds = (LAS unsigned char*)ldsg;
    const int tid = launder_tid(), lane = tid & 63, wid = __builtin_amdgcn_readfirstlane(tid >> 6), r32 = lane & 31, hi = lane >> 5;
    const int map = wid >> 2, qs = wid & 3;
    const int q0 = qb * 128, qmin = q0 + qs * 32, myq = qmin + r32;
    const size_t rowbase = (size_t)b * SEQ;
    constexpr int RS = 272, TILE = 64 * RS;
    LAS float* wsf = (LAS float*)(lds + 4 * TILE) + wid * 32;
    const LAS float* lut = (const LAS float*)(lds + LDS_LUT) + (8 + h) * 129;
    bf16x8 qr[4];
    { const bf16* qp = P + (rowbase + myq) * PW + COL_QB + h * 128 + map * 64 + hi * 8;
#pragma unroll
      for (int d0 = 0; d0 < 4; ++d0) qr[d0] = *(const bf16x8*)(qp + d0 * 16); }
    const int NT = 2 * qb + 2;
    f32x16 o[4];
#pragma unroll
    for (int d = 0; d < 4; ++d)
#pragma unroll
        for (int i = 0; i < 16; ++i) o[d][i] = 0.f;
    float mrun = -INFINITY, lrun = 0.f;
    const float SC = 0.125f * LOG2E;
    const int lrow0 = tid >> 4, lc16 = tid & 15;
    const bf16* kg = P + (rowbase + lrow0) * PW + COL_KB + h * 128 + lc16 * 8;
    const bf16* vg = P + (rowbase + lrow0) * PW + COL_VB + h * 128 + lc16 * 8;
    u32x4 kr[2], vr[2];
#pragma unroll
    for (int i = 0; i < 2; ++i) { kr[i] = *(const u32x4*)(kg + (size_t)(32 * i) * PW); vr[i] = *(const u32x4*)(vg + (size_t)(32 * i) * PW); }
    const int q4 = (lane & 15) >> 2;
    const int vcol = (16 * ((lane >> 4) & 1) + 4 * (lane & 3)) * 2;
    for (int t = 0; t < NT; ++t) {
        const int buf = t & 1;
        LAS unsigned char* Kb = lds + buf * TILE; LAS unsigned char* Vb = lds + (2 + buf) * TILE;
#pragma unroll
        for (int i = 0; i < 2; ++i) { *(LAS u32x4*)(Kb + (lrow0 + 32 * i) * RS + lc16 * 16) = kr[i]; *(LAS u32x4*)(Vb + (lrow0 + 32 * i) * RS + lc16 * 16) = vr[i]; }
        __syncthreads();
        if (t + 1 < NT) {
#pragma unroll
            for (int i = 0; i < 2; ++i) { kr[i] = *(const u32x4*)(kg + (size_t)(64 * (t + 1) + 32 * i) * PW); vr[i] = *(const u32x4*)(vg + (size_t)(64 * (t + 1) + 32 * i) * PW); }
        }
        const int kb0 = 64 * t;
        if (kb0 > qmin + 31) continue;
        f32x16 p0, p1;
#pragma unroll
        for (int i = 0; i < 16; ++i) { p0[i] = 0.f; p1[i] = 0.f; }
#pragma unroll
        for (int d0 = 0; d0 < 4; ++d0) {
            const bf16x8 a0 = *(const LAS bf16x8*)(Kb + r32 * RS + (map * 64 + d0 * 16 + hi * 8) * 2);
            const bf16x8 a1 = *(const LAS bf16x8*)(Kb + (32 + r32) * RS + (map * 64 + d0 * 16 + hi * 8) * 2);
            p0 = __builtin_amdgcn_mfma_f32_32x32x16_bf16(a0, qr[d0], p0, 0, 0, 0);
            p1 = __builtin_amdgcn_mfma_f32_32x32x16_bf16(a1, qr[d0], p1, 0, 0, 0);
        }
        if (qmin - (kb0 + 63) >= 128) {
            const float c = lut[128];
#pragma unroll
            for (int i = 0; i < 16; ++i) { p0[i] = p0[i] * SC + c; p1[i] = p1[i] * SC + c; }
        } else {
#pragma unroll
            for (int i = 0; i < 16; ++i) {
                const int n0 = myq - (kb0 + crow(i, hi)), n1 = n0 - 32;
                const float b0 = lut[n0 < 0 ? 0 : (n0 > 128 ? 128 : n0)], b1 = lut[n1 < 0 ? 0 : (n1 > 128 ? 128 : n1)];
                p0[i] = n0 < 0 ? -INFINITY : p0[i] * SC + b0; p1[i] = n1 < 0 ? -INFINITY : p1[i] * SC + b1;
            }
        }
        float rm = fmaxf(p0[0], p1[0]);
#pragma unroll
        for (int i = 1; i < 16; ++i) rm = fmaxf(rm, fmaxf(p0[i], p1[i]));
        rm = fmaxf(rm, __shfl_xor(rm, 32));
        const float mnew = fmaxf(mrun, rm);
        const float f = __builtin_amdgcn_exp2f(mrun - mnew);
        mrun = mnew;
        float ls = 0.f;
#pragma unroll
        for (int i = 0; i < 16; ++i) { p0[i] = __builtin_amdgcn_exp2f(p0[i] - mnew); p1[i] = __builtin_amdgcn_exp2f(p1[i] - mnew); ls += p0[i] + p1[i]; }
        lrun = lrun * f + ls;
        if (__any(f != 1.0f)) {
            if (hi == 0) wsf[r32] = f;
            __builtin_amdgcn_wave_barrier();
#pragma unroll
            for (int i = 0; i < 16; ++i) { const float fi = wsf[crow(i, hi)];
#pragma unroll
                for (int d = 0; d < 4; ++d) o[d][i] *= fi; }
            __builtin_amdgcn_wave_barrier();
        }
        bf16x8 pa[4]; pa[0] = pack8(p0, 0); pa[1] = pack8(p0, 1); pa[2] = pack8(p1, 0); pa[3] = pack8(p1, 1);
#pragma unroll
        for (int d0 = 0; d0 < 4; ++d0)
#pragma unroll
            for (int ks = 0; ks < 4; ++ks) {
                const LAS unsigned char* vp = Vb + (16 * ks + 4 * hi + q4) * RS + d0 * 64 + vcol;
                const s16x4 lo = vtr(vp), hh = vtr(vp + 8 * RS);
                const bf16x8 vf = __builtin_shufflevector(lo, hh, 0, 1, 2, 3, 4, 5, 6, 7);
                o[d0] = __builtin_amdgcn_mfma_f32_32x32x16_bf16(pa[ks], vf, o[d0], 0, 0, 0);
            }
    }
    lrun += __shfl_xor(lrun, 32);
    if (hi == 0) wsf[r32] = 1.0f / lrun;
    __builtin_amdgcn_wave_barrier();
#pragma unroll
    for (int i = 0; i < 16; ++i) { const float fi = wsf[crow(i, hi)];
#pragma unroll
        for (int d = 0; d < 4; ++d) o[d][i] *= fi; }
    __syncthreads();
    LAS float* X = (LAS float*)lds;
    if (map == 1) {
#pragma unroll
        for (int d = 0; d < 4; ++d)
#pragma unroll
            for (int i = 0; i < 16; ++i) X[(qs * 32 + crow(i, hi)) * 128 + 32 * d + r32] = o[d][i];
    }
    __syncthreads();
    if (map == 0) {
        float gsub[4];
#pragma unroll
        for (int d = 0; d < 4; ++d) gsub[d] = subg[32 * d + r32];
#pragma unroll
        for (int i = 0; i < 16; ++i) {
            float ss = 0.f;
#pragma unroll
            for (int d = 0; d < 4; ++d) { const float v = o[d][i] - lam_full * X[(qs * 32 + crow(i, hi)) * 128 + 32 * d + r32]; o[d][i] = v; ss += v * v; }
#pragma unroll
            for (int sft = 1; sft < 32; sft <<= 1) ss += __shfl_xor(ss, sft);
            const float rs = (1.0f / sqrtf(ss * (1.f / 128.f) + LN_EPS)) * oscale;
            bf16* orow = O + (rowbase + qmin + crow(i, hi)) * DM + 512 + h * 128 + r32;
#pragma unroll
            for (int d = 0; d < 4; ++d) orow[32 * d] = (bf16)f2bf(o[d][i] * rs * gsub[d]);
        }
    }
    __syncthreads();
}

__device__ __forceinline__ void cnt_ge(int& cnt, unsigned k, unsigned c) {
    asm volatile("v_cmp_ge_u32_e32 vcc, %1, %2\n\tv_addc_co_u32_e32 %0, vcc, 0, %0, vcc" : "+v"(cnt) : "v"(k), "v"(c) : "vcc");
}
__device__ __forceinline__ unsigned sel_addr(int& pos, unsigned k, unsigned p, unsigned base, unsigned dummy) {
    unsigned a;
    asm volatile("v_cmp_ge_u32_e32 vcc, %2, %3\n\tv_lshl_add_u32 %1, %0, 2, %4\n\tv_cndmask_b32_e32 %1, %5, %1, vcc\n\tv_addc_co_u32_e32 %0, vcc, 0, %0, vcc"
                 : "+v"(pos), "=&v"(a) : "v"(k), "v"(p), "v"(base), "v"(dummy) : "vcc");
    return a;
}
__device__ __forceinline__ void dsa_unit(unsigned char* ldsg, const bf16* P, const bf16* IK, unsigned long long* bits, float* scr, int b, int t0) {
    LAS unsigned char* lds = (LAS unsigned char*)ldsg;
    const int tid = launder_tid(), lane = tid & 63, wid = __builtin_amdgcn_readfirstlane(tid >> 6);
    const size_t rowbase = (size_t)b * SEQ;
    {
        const int c16 = lane & 15, g4 = lane >> 4;
        const bf16* qrow = P + (rowbase + t0 + c16) * PW;
        bf16x8 bq[8][2];
#pragma unroll
        for (int hh = 0; hh < 8; ++hh)
#pragma unroll
            for (int ks = 0; ks < 2; ++ks) bq[hh][ks] = *(const bf16x8*)(qrow + COL_IQ + hh * 64 + ks * 32 + 8 * g4);
        float w[8];
        { const u32x4 wv = *(const u32x4*)(qrow + COL_IW); w[0] = bflo(wv.x); w[1] = bfhi(wv.x); w[2] = bflo(wv.y); w[3] = bfhi(wv.y); w[4] = bflo(wv.z); w[5] = bfhi(wv.z); w[6] = bflo(wv.w); w[7] = bfhi(wv.w); }
        const int nkt = t0 / 16 + 1;
        for (int kt = wid; kt < nkt; kt += NWAVES) {
            const bf16* krow = IK + (rowbase + 16 * kt + c16) * 64 + 8 * g4;
            const bf16x8 a0 = *(const bf16x8*)krow, a1 = *(const bf16x8*)(krow + 32);
            f32x4 sc = {0.f, 0.f, 0.f, 0.f};
#pragma unroll
            for (int hh = 0; hh < 8; ++hh) {
                f32x4 z = {0.f, 0.f, 0.f, 0.f};
                z = __builtin_amdgcn_mfma_f32_16x16x32_bf16(a0, bq[hh][0], z, 0, 0, 0);
                z = __builtin_amdgcn_mfma_f32_16x16x32_bf16(a1, bq[hh][1], z, 0, 0, 0);
#pragma unroll
                for (int e = 0; e < 4; ++e) sc[e] += w[hh] * fmaxf(z[e], 0.f);
            }
            *(f32x4*)(scr + (size_t)c16 * SEQ + 16 * kt + 4 * g4) = sc;
        }
    }
    __syncthreads();
    for (int qq = wid; qq < 16; qq += NWAVES) {
        const int t = t0 + qq;
        const float* row = scr + (size_t)qq * SEQ;
        unsigned k[128];
#pragma unroll
        for (int r = 0; r < 128; ++r) {
            unsigned key = 0u;
            const int tl = t - r * 64;
            if (tl >= 0) {
                const unsigned u = __builtin_bit_cast(unsigned, row[r * 64 + lane]); key = (u & 0x80000000u) ? ~u : (u | 0x80000000u);
                if (lane > tl) key = 0u;
            }
            k[r] = key;
        }
        unsigned pth = 1u, ptie = 0u; int need = 0, cgt = 0;
        if (t >= 256) {
            pth = 0u; int cntge = 0;
            for (int bit = 31; bit >= 0; --bit) {
                const unsigned c = pth | (1u << bit);
                int c0 = 0;
#pragma unroll
                for (int r = 0; r < 128; ++r) cnt_ge(c0, k[r], c);
                const int cnt = wave_sum_i(c0);
                if (cnt >= 256) { pth = c; cntge = cnt; }
                if (cnt == 256) break;
            }
            if (cntge != 256) {
                int c0 = 0;
#pragma unroll
                for (int r = 0; r < 128; ++r) cnt_ge(c0, k[r], pth + 1u);
                cgt = wave_sum_i(c0); need = 256 - cgt; ptie = pth; pth = pth + 1u;
            }
        }
        {
            unsigned w0lo = 0u, w0hi = 0u, w1lo = 0u, w1hi = 0u;
#define WL1(r) { const unsigned long long m0 = __ballot(k[r] >= pth), m1 = __ballot(k[(r) + 64] >= pth); \
                asm volatile("v_writelane_b32 %0, %1, " #r : "+v"(w0lo) : "s"((unsigned)m0)); asm volatile("v_writelane_b32 %0, %1, " #r : "+v"(w0hi) : "s"((unsigned)(m0 >> 32))); \
                asm volatile("v_writelane_b32 %0, %1, " #r : "+v"(w1lo) : "s"((unsigned)m1)); asm volatile("v_writelane_b32 %0, %1, " #r : "+v"(w1hi) : "s"((unsigned)(m1 >> 32))); \
                __builtin_amdgcn_sched_barrier(0); }
#define WL8(a) WL1(a##0) WL1(a##1) WL1(a##2) WL1(a##3) WL1(a##4) WL1(a##5) WL1(a##6) WL1(a##7)
            WL1(0) WL1(1) WL1(2) WL1(3) WL1(4) WL1(5) WL1(6) WL1(7) WL1(8) WL1(9)
            WL1(10) WL1(11) WL1(12) WL1(13) WL1(14) WL1(15) WL1(16) WL1(17) WL1(18) WL1(19)
            WL1(20) WL1(21) WL1(22) WL1(23) WL1(24) WL1(25) WL1(26) WL1(27) WL1(28) WL1(29)
            WL1(30) WL1(31) WL1(32) WL1(33) WL1(34) WL1(35) WL1(36) WL1(37) WL1(38) WL1(39)
            WL1(40) WL1(41) WL1(42) WL1(43) WL1(44) WL1(45) WL1(46) WL1(47) WL1(48) WL1(49)
            WL1(50) WL1(51) WL1(52) WL1(53) WL1(54) WL1(55) WL1(56) WL1(57) WL1(58) WL1(59)
            WL1(60) WL1(61) WL1(62) WL1(63)
#undef WL1
#undef WL8
            u32x2* brow = (u32x2*)(bits + (rowbase + t) * 128);
            u32x2 v0; v0.x = w0lo; v0.y = w0hi; u32x2 v1; v1.x = w1lo; v1.y = w1hi;
            brow[lane] = v0; brow[64 + lane] = v1;
        }
        if (need > 0) {
            asm volatile("s_waitcnt vmcnt(0)" ::: "memory");
            int filled = 0;
#pragma unroll 1
            for (int r = 0; r * 64 <= t && filled < need; ++r) {
                const int s = r * 64 + lane; unsigned key = 0u;
                if (s <= t) { const unsigned u = __builtin_bit_cast(unsigned, row[s]); key = (u & 0x80000000u) ? ~u : (u | 0x80000000u); }
                const bool eq = key == ptie;
                const unsigned long long me = __ballot(eq);
                const int pe = filled + (int)__builtin_amdgcn_mbcnt_hi((unsigned)(me >> 32), __builtin_amdgcn_mbcnt_lo((unsigned)me, 0u));
                const unsigned long long take = __ballot(eq && pe < need);
                if (lane == 0 && take != 0ull) atomicOr(bits + (rowbase + t) * 128 + r, take);
                filled += __popcll(me);
            }
        }
    }
    __syncthreads();
}

__device__ __forceinline__ void dsa_attn_unit(unsigned char* ldsg, const bf16* P, const unsigned long long* bits, bf16* O, int b, int h, int qb) {
    LAS unsigned char* lds = (LAS unsigned char*)ldsg;
    const int tid = launder_tid(), lane = tid & 63, wid = __builtin_amdgcn_readfirstlane(tid >> 6), r32 = lane & 31, hi = lane >> 5;
    const int q0 = qb * 256, qmin = q0 + wid * 32, myq = qmin + r32;
    const size_t rowbase = (size_t)b * SEQ;
    constexpr int RS = 144, TILE = 64 * RS;
    LAS float* wsf = (LAS float*)(lds + 4 * TILE) + wid * 32;
    const LAS float* lut = (const LAS float*)(lds + LDS_LUT) + h * 129;
    bf16x8 qr[4];
    { const bf16* qp = P + (rowbase + myq) * PW + COL_QA + h * 64 + hi * 8;
#pragma unroll
      for (int d0 = 0; d0 < 4; ++d0) qr[d0] = *(const bf16x8*)(qp + d0 * 16); }
    const int NT = 4 * qb + 4;
    f32x16 o[2];
#pragma unroll
    for (int d = 0; d < 2; ++d)
#pragma unroll
        for (int i = 0; i < 16; ++i) o[d][i] = 0.f;
    float mrun = -INFINITY, lrun = 0.f;
    const float SC = 0.125f * LOG2E;
    const int lrow = tid >> 3, lc16 = tid & 7;
    const bf16* kg = P + (rowbase + lrow) * PW + COL_KA + h * 64 + lc16 * 8;
    const bf16* vg = P + (rowbase + lrow) * PW + COL_VA + h * 64 + lc16 * 8;
    u32x4 kr = *(const u32x4*)kg, vr = *(const u32x4*)vg;
    const u32x2* brow = (const u32x2*)(bits + (rowbase + myq) * 128);
    u32x2 wnext = brow[0];
    const int q4 = (lane & 15) >> 2;
    const int vcol = (16 * ((lane >> 4) & 1) + 4 * (lane & 3)) * 2;
    for (int t = 0; t < NT; ++t) {
        const int buf = t & 1;
        LAS unsigned char* Kb = lds + buf * TILE; LAS unsigned char* Vb = lds + (2 + buf) * TILE;
        *(LAS u32x4*)(Kb + lrow * RS + lc16 * 16) = kr; *(LAS u32x4*)(Vb + lrow * RS + lc16 * 16) = vr;
        __syncthreads();
        const u32x2 w = wnext;
        if (t + 1 < NT) { kr = *(const u32x4*)(kg + (size_t)(64 * (t + 1)) * PW); vr = *(const u32x4*)(vg + (size_t)(64 * (t + 1)) * PW); wnext = brow[t + 1]; }
        const int kb0 = 64 * t;
        if (kb0 > qmin + 31) continue;
        if (!__any((w.x | w.y) != 0u)) continue;
        f32x16 p0, p1;
#pragma unroll
        for (int i = 0; i < 16; ++i) { p0[i] = 0.f; p1[i] = 0.f; }
#pragma unroll
        for (int d0 = 0; d0 < 4; ++d0) {
            const bf16x8 a0 = *(const LAS bf16x8*)(Kb + r32 * RS + (d0 * 16 + hi * 8) * 2);
            const bf16x8 a1 = *(const LAS bf16x8*)(Kb + (32 + r32) * RS + (d0 * 16 + hi * 8) * 2);
            p0 = __builtin_amdgcn_mfma_f32_32x32x16_bf16(a0, qr[d0], p0, 0, 0, 0);
            p1 = __builtin_amdgcn_mfma_f32_32x32x16_bf16(a1, qr[d0], p1, 0, 0, 0);
        }
        const unsigned wl = w.x >> (4 * hi), wh = w.y >> (4 * hi);
        if (qmin - (kb0 + 63) >= 128) {
            const float c = lut[128];
#pragma unroll
            for (int i = 0; i < 16; ++i) { const unsigned bm = 1u << ((i & 3) + 8 * (i >> 2));
                p0[i] = (wl & bm) ? p0[i] * SC + c : -INFINITY; p1[i] = (wh & bm) ? p1[i] * SC + c : -INFINITY; }
        } else {
#pragma unroll
            for (int i = 0; i < 16; ++i) { const unsigned bm = 1u << ((i & 3) + 8 * (i >> 2));
                const int n0 = myq - (kb0 + crow(i, hi)), n1 = n0 - 32;
                const float b0 = lut[n0 < 0 ? 0 : (n0 > 128 ? 128 : n0)], b1 = lut[n1 < 0 ? 0 : (n1 > 128 ? 128 : n1)];
                p0[i] = (wl & bm) ? p0[i] * SC + b0 : -INFINITY; p1[i] = (wh & bm) ? p1[i] * SC + b1 : -INFINITY; }
        }
        float rm = fmaxf(p0[0], p1[0]);
#pragma unroll
        for (int i = 1; i < 16; ++i) rm = fmaxf(rm, fmaxf(p0[i], p1[i]));
        rm = fmaxf(rm, __shfl_xor(rm, 32));
        const float mnew = fmaxf(mrun, rm);
        const float msafe = (mnew == -INFINITY) ? 0.f : mnew;
        const float f = (mrun == -INFINITY) ? 1.0f : __builtin_amdgcn_exp2f(mrun - msafe);
        mrun = mnew;
        float ls = 0.f;
#pragma unroll
        for (int i = 0; i < 16; ++i) { p0[i] = __builtin_amdgcn_exp2f(p0[i] - msafe); p1[i] = __builtin_amdgcn_exp2f(p1[i] - msafe); ls += p0[i] + p1[i]; }
        lrun = lrun * f + ls;
        if (__any(f != 1.0f)) {
            if (hi == 0) wsf[r32] = f;
            __builtin_amdgcn_wave_barrier();
#pragma unroll
            for (int i = 0; i < 16; ++i) { const float fi = wsf[crow(i, hi)]; o[0][i] *= fi; o[1][i] *= fi; }
            __builtin_amdgcn_wave_barrier();
        }
        bf16x8 pa[4]; pa[0] = pack8(p0, 0); pa[1] = pack8(p0, 1); pa[2] = pack8(p1, 0); pa[3] = pack8(p1, 1);
#pragma unroll
        for (int d0 = 0; d0 < 2; ++d0)
#pragma unroll
            for (int ks = 0; ks < 4; ++ks) {
                const LAS unsigned char* vp = Vb + (16 * ks + 4 * hi + q4) * RS + d0 * 64 + vcol;
                const s16x4 lo = vtr(vp), hh = vtr(vp + 8 * RS);
                const bf16x8 vf = __builtin_shufflevector(lo, hh, 0, 1, 2, 3, 4, 5, 6, 7);
                o[d0] = __builtin_amdgcn_mfma_f32_32x32x16_bf16(pa[ks], vf, o[d0], 0, 0, 0);
            }
    }
    lrun += __shfl_xor(lrun, 32);
    if (hi == 0) wsf[r32] = 1.0f / lrun;
    __builtin_amdgcn_wave_barrier();
#pragma unroll
    for (int i = 0; i < 16; ++i) { const float fi = wsf[crow(i, hi)];
        bf16* orow = O + (rowbase + qmin + crow(i, hi)) * DM + h * 64 + r32;
        orow[0] = (bf16)f2bf(o[0][i] * fi); orow[32] = (bf16)f2bf(o[1][i] * fi); }
    __syncthreads();
}

__device__ __forceinline__ void att_phase(const Params& p, unsigned char* ldsg, int layer) {
    const int tid = launder_tid();
    const int j = layer >> 1;
    unsigned char* ws = p.ws;
    const bf16* P = (const bf16*)(ws + WS_PB); const bf16* IK = (const bf16*)(ws + WS_IK); bf16* O = (bf16*)(ws + WS_XB);
    float* scr = (float*)(ws + WS_SCR) + (size_t)blockIdx.x * 16 * SEQ;
    LAS float* lut = (LAS float*)((LAS unsigned char*)ldsg + LDS_LUT);
    LAS float* misc = lut + 12 * 129;
    const float* relb = p.in[5];
    for (int i = tid; i < 12 * 129; i += NTHREADS) { const int hd = i / 129, n = i % 129; lut[i] = relb[t5_bucket(n) * 12 + hd] * LOG2E; }
    if (tid < 64) {
        const float* lam = p.in[9] + (size_t)j * 4 * 64;
        const float a = wave_sum(lam[tid] * lam[64 + tid]), bb = wave_sum(lam[128 + tid] * lam[192 + tid]);
        if (tid == 0) misc[0] = a, misc[1] = bb;
    }
    __syncthreads();
    const float lam_init = 0.8f - 0.6f * expf(-0.3f * (float)layer);
    const float lam_full = expf(misc[0]) - expf(misc[1]) + lam_init;
    const float* subg = p.in[10] + (size_t)j * 128;
    for (int rep = 0; rep < DUP_DIFF; ++rep)
    for (int c = blockIdx.x; c < 256; c += gridDim.x) {
        const int b = c >> 7, h = (c >> 5) & 3, i = c & 31;
        if (EN_DIFF) diff_unit(ldsg, P, O, b, h, 63 - i, lam_full, 1.0f - lam_init, subg);
        if (EN_DIFF) diff_unit(ldsg, P, O, b, h, i, lam_full, 1.0f - lam_init, subg);
    }
    unsigned long long* bits = (unsigned long long*)(ws + WS_BITS);
    for (int rep = 0; rep < DUP_DSA; ++rep)
    for (int c = blockIdx.x; c < 256; c += gridDim.x) {
#pragma unroll 1
        for (int kq = 0; kq < 4; ++kq) {
            const int id = (kq == 0) ? 1023 - c : (kq == 1) ? 512 + c : (kq == 2) ? 511 - c : c;
            if (EN_DSA) dsa_unit(ldsg, P, IK, bits, scr, id & 1, (id >> 1) * 16);
        }
    }
}
__device__ __forceinline__ void attb_phase(const Params& p, unsigned char* ldsg) {
    const int tid = launder_tid();
    unsigned char* ws = p.ws;
    const bf16* P = (const bf16*)(ws + WS_PB); bf16* O = (bf16*)(ws + WS_XB);
    const unsigned long long* bits = (const unsigned long long*)(ws + WS_BITS);
    LAS float* lut = (LAS float*)((LAS unsigned char*)ldsg + LDS_LUT);
    const float* relb = p.in[5];
    for (int i = tid; i < 8 * 129; i += NTHREADS) { const int hd = i / 129, n = i % 129; lut[i] = relb[t5_bucket(n) * 12 + hd] * LOG2E; }
    __syncthreads();
    for (int rep = 0; rep < DUP_ATTB; ++rep)
    for (int c = blockIdx.x; c < 256; c += gridDim.x) {
        const int b = c >> 7, h = (c >> 4) & 7, i = c & 15;
        dsa_attn_unit(ldsg, P, bits, O, b, h, 31 - i);
        dsa_attn_unit(ldsg, P, bits, O, b, h, i);
    }
}

#define XB_TMO      128
#define XB_XCNT(j)  (256  + 64 * (j))
#define XB_XSUB(j)  (1280 + 64 * (j))
#define XB_XGEN(j)  (2304 + 64 * (j))
#define XB_TOP      3328
#define XB_TOPGEN   3392
#define XCD_BAR_WORDS 3456
#define XB_SPIN_CAP (1u << 18)

__device__ __forceinline__ unsigned xb_ld(unsigned* p)              { return __hip_atomic_load(p, __ATOMIC_RELAXED, __HIP_MEMORY_SCOPE_AGENT); }
__device__ __forceinline__ unsigned xb_add(unsigned* p, unsigned v) { return __hip_atomic_fetch_add(p, v, __ATOMIC_RELAXED, __HIP_MEMORY_SCOPE_AGENT); }
__device__ __forceinline__ unsigned xb_xcc_id() { return (unsigned)__builtin_amdgcn_s_getreg((3 << 11) | 20) & 0xFu; }
#define XB_SPIN(cond, bar) do { unsigned _sp = 0; while (cond) { __builtin_amdgcn_s_sleep(1); \
    if ((++_sp & 255u) == 0u) { if (xb_ld(&(bar)[XB_TMO])) break; if (_sp > XB_SPIN_CAP) { atomicAdd(&(bar)[XB_TMO], 1u); break; } } } } while (0)

struct XcdBarrier {
    unsigned* bar; unsigned x;
    volatile LAS unsigned* st;
};

__device__ __forceinline__ XcdBarrier xcd_barrier_post(unsigned* bar, volatile LAS unsigned* st) {
    XcdBarrier b; b.bar = bar; b.x = xb_xcc_id(); b.st = st;
    if (threadIdx.x == 0) (void)xb_add(&bar[XB_XCNT(b.x)], 1u);
    return b;
}
__device__ __forceinline__ void xcd_barrier_complete(unsigned* bar, unsigned x, unsigned& nloc, unsigned& nx) {
    const unsigned G = gridDim.x * gridDim.y * gridDim.z;
    unsigned sum, cnt, mine, sp = 0u;
    for (;;) {
        sum = 0u; cnt = 0u; mine = 0u;
#pragma unroll
        for (unsigned j = 0; j < 16; ++j) { const unsigned c = xb_ld(&bar[XB_XCNT(j)]); sum += c; cnt += (c > 0u) ? 1u : 0u; mine = (j == x) ? c : mine; }
        if (sum == G) break;
        __builtin_amdgcn_s_sleep(1);
        if ((++sp & 255u) == 0u) { if (xb_ld(&bar[XB_TMO])) break; if (sp > XB_SPIN_CAP) { atomicAdd(&bar[XB_TMO], 1u); break; } }
    }
    nloc = mine > 0u ? mine : 1u; nx = cnt > 0u ? cnt : 1u;
}

__device__ __forceinline__ void xcd_barrier(const XcdBarrier& b) {
    asm volatile("s_waitcnt vmcnt(0)" ::: "memory");
    __syncthreads();
    if (threadIdx.x == 0) {
        unsigned* bar = b.bar;
        __builtin_amdgcn_s_waitcnt(0);
        unsigned nloc = b.st[0], nx = b.st[1];
        if (nloc == 0u) { xcd_barrier_complete(bar, b.x, nloc, nx); b.st[0] = nloc; b.st[1] = nx; }
        const unsigned old = xb_add(&bar[XB_XSUB(b.x)], 1u);
        const unsigned gen = old / nloc;
        if (old + 1u == (gen + 1u) * nloc) {
            __builtin_amdgcn_fence(__ATOMIC_RELEASE, "agent");
            asm volatile("s_waitcnt vmcnt(0)" ::: "memory");
            const unsigned og = xb_add(&bar[XB_TOP], 1u);
            const unsigned tg = og / nx;
            if (og + 1u == (tg + 1u) * nx) xb_add(&bar[XB_TOPGEN], 1u);
            else XB_SPIN(xb_ld(&bar[XB_TOPGEN]) == tg, bar);
            __builtin_amdgcn_fence(__ATOMIC_ACQUIRE, "agent");
            xb_add(&bar[XB_XGEN(b.x)], 1u);
            asm volatile("s_waitcnt vmcnt(0)" ::: "memory");
        } else {
            XB_SPIN(xb_ld(&bar[XB_XGEN(b.x)]) == gen, bar);
            __builtin_amdgcn_fence(__ATOMIC_ACQUIRE, "agent");
            asm volatile("s_waitcnt vmcnt(0)" ::: "memory");
        }
    }
    __syncthreads();
}

__global__ void __launch_bounds__(NTHREADS, 2) fwd_kernel(Params p) {
    extern __shared__ __attribute__((aligned(16))) unsigned char lds[];
    cg::grid_group grid = cg::this_grid();
    volatile LAS unsigned* bst = (volatile LAS unsigned*)((LAS unsigned char*)lds + LDS_LUT + 7168);
    if (threadIdx.x == 0) { bst[0] = 0u; bst[1] = 0u; }
    __syncthreads();
    XcdBarrier xbar = xcd_barrier_post((unsigned*)(p.ws + WS_CTL), bst);
    unsigned char* ws = p.ws;
    bf16* XB = (bf16*)(ws + WS_XB); bf16* PB = (bf16*)(ws + WS_PB); float* Y = (float*)(ws + WS_Y);
    for (int ph = p.ph_lo; ph < p.ph_hi; ++ph) {
        if (ph > p.ph_lo) { if (ph == 1) grid.sync(); else xcd_barrier(xbar); for (int e_ = 0; e_ < DUP_SYNC; ++e_) xcd_barrier(xbar); }
        if (ph == 0) { for (int e_ = 0; e_ < DUP_PRO; ++e_) prologue_phase(p, lds); continue; }
        int l, s;
        if (ph < 13) { l = 0; s = ph - 1; } else if (ph < 23) { l = 1; s = ph - 13; } else if (ph < 35) { l = 2; s = ph - 23; } else { l = 3; s = ph - 35; }
        if (l & 1) s = (s < 4) ? s : (s == 4) ? 5 : s + 2;
        const int j = l >> 1;
        const float* base = (ph <= 2) ? p.in[0] : p.out;
        for (int rep_ = 0; rep_ < (((DUP_PH >> s) & 1) ? 2 : 1); ++rep_)
        if (s == 0 || s == 9) {
            const int f = (s == 9);
            pg8::Gemm g{XB, (const bf16*)(ws + WS_WFI + (size_t)(l * 2 + f) * SZ_WFI), MTOK, 5632, 1024}; pg8::StaticOrder S; S.init(MTOK, 5632, gridDim.x, blockIdx.x);
            pg8::EpiAct E{PB, DFF, 0};
            if (EN_GEMM1) pg8::gemm_phase<pg8::EpiAct, pg8::StaticOrder, true, true>((PG8_LAS unsigned char*)lds, g, S, E);
        } else if (s == 3 && (l & 1)) {
            pg8::Gemm g{XB, (const bf16*)(ws + WS_WCI + (size_t)j * SZ_WCI), MTOK, 2048, 1024}; pg8::StaticOrder S; S.init(MTOK, 2048, gridDim.x, blockIdx.x);
            pg8::EpiAct E{PB, DM, 1};
            if (EN_GEMM1) pg8::gemm_phase<pg8::EpiAct, pg8::StaticOrder, true, true>((PG8_LAS unsigned char*)lds, g, S, E);
        } else if (s == 1 || s == 10) {
            const int f = (s == 10);
            pg8::Gemm g{PB, (const bf16*)(ws + WS_WFO + (size_t)(l * 2 + f) * SZ_WFO), MTOK, DM, DFF}; pg8::StaticOrder S; S.init(MTOK, DM, gridDim.x, blockIdx.x);
            pg8::EpiRes E{base, Y, DM, ALPHA, 0.5f};
            if (EN_GEMM2) pg8::gemm_phase<pg8::EpiRes, pg8::StaticOrder, true, true>((PG8_LAS unsigned char*)lds, g, S, E);
        } else if (s == 7) {
            const bf16* Wt = (l & 1) ? (const bf16*)(ws + WS_WCO + (size_t)j * SZ_WCO) : (const bf16*)(ws + WS_WMO + (size_t)j * SZ_WMO);
            pg8::Gemm g{XB, Wt, MTOK, DM, DM}; pg8::StaticOrder S; S.init(MTOK, DM, gridDim.x, blockIdx.x);
            pg8::EpiRes E{base, Y, DM, ALPHA, 1.0f};
            if (EN_GEMM2) pg8::gemm_phase<pg8::EpiRes, pg8::StaticOrder, true, true>((PG8_LAS unsigned char*)lds, g, S, E);
        } else if (s == 3) {
            pg8::Gemm g{XB, (const bf16*)(ws + WS_WMI + (size_t)j * SZ_WMI), MTOK, PW, 1024}; pg8::StaticOrder S; S.init(MTOK, PW, gridDim.x, blockIdx.x);
            pg8::EpiBf16 E{PB, PW};
            if (EN_GEMM3) pg8::gemm_phase<pg8::EpiBf16, pg8::StaticOrder, true, true>((PG8_LAS unsigned char*)lds, g, S, E);
        } else if (s == 2 || s == 8 || s == 11) {
            const int which = (s == 2) ? 0 : (s == 8) ? 1 : 2;
            if (EN_LN) ln_phase(Y, p.in[3] + (size_t)(l * 3 + which) * DM, p.in[4] + (size_t)(l * 3 + which) * DM, p.out, XB);
        } else if (s == 4) {
            if (EN_IKLN) ikln_phase(PB, p.in[7] + (size_t)j * 64, p.in[8] + (size_t)j * 64, (bf16*)(ws + WS_IK));
        } else if (s == 5 && !(l & 1)) {
            att_phase(p, lds, l);
        } else if (s == 6) {
            attb_phase(p, lds);
        } else if (s == 5) {
            for (int e_ = 0; e_ < DUP_CONV; ++e_) conv_phase(PB, p.in[13] + (size_t)j * 31 * DM, p.in[14] + (size_t)j * DM, p.in[15] + (size_t)j * DM, p.in[16] + (size_t)j * DM, XB);
        }
    }
}
constexpr int NPHASES = 45;

#ifndef ONE_LAUNCH
#define ONE_LAUNCH 1
#endif
extern "C" void kernel_launch(void* const* d_in, const int* in_sizes, int n_in, void* d_out, int out_size, void* d_ws, size_t ws_size, hipStream_t stream) {
    static int grid = 0;
    if (grid == 0) {
        if (n_in != 18 || in_sizes[0] != MTOK * DM || out_size != MTOK * DM || ws_size < WS_END) { fprintf(stderr, "kernel_launch: unexpected shapes (n_in %d, in0 %d, out %d, ws %zu)\n", n_in, n_in > 0 ? in_sizes[0] : -1, out_size, ws_size); grid = -1; return; }
        int dev = 0, cus = 0, per_cu = 0;
        if (hipGetDevice(&dev) != hipSuccess || hipDeviceGetAttribute(&cus, hipDeviceAttributeMultiprocessorCount, dev) != hipSuccess) { grid = -1; return; }
        if (hipFuncSetAttribute((const void*)fwd_kernel, hipFuncAttributeMaxDynamicSharedMemorySize, LDS_BYTES) != hipSuccess) { fprintf(stderr, "kernel_launch: hipFuncSetAttribute failed\n"); grid = -1; return; }
        if (hipOccupancyMaxActiveBlocksPerMultiprocessor(&per_cu, (const void*)fwd_kernel, NTHREADS, LDS_BYTES) != hipSuccess || per_cu < 1) { fprintf(stderr, "kernel_launch: occupancy query gave %d\n", per_cu); per_cu = 1; }
        (void)hipGetLastError();
        grid = cus;
    }
    if (grid < 0) return;
    Params p{};
    for (int i = 0; i < 18; ++i) p.in[i] = (const float*)d_in[i];
    p.out = (float*)d_out; p.ws = (unsigned char*)d_ws;
    if (hipMemsetAsync((char*)d_ws + WS_CTL, 0, CTL_BYTES, stream) != hipSuccess) { fprintf(stderr, "kernel_launch: memset failed\n"); return; }
#if ONE_LAUNCH
    p.ph_lo = 0; p.ph_hi = NPHASES;
    void* args[] = {&p};
    hipError_t e = hipLaunchCooperativeKernel((const void*)fwd_kernel, dim3(grid), dim3(NTHREADS), args, LDS_BYTES, stream);
    if (e != hipSuccess) fprintf(stderr, "cooperative launch failed: %s (grid %d)\n", hipGetErrorString(e), grid);
#else
    for (int ph = 0; ph < NPHASES; ++ph) { p.ph_lo = ph; p.ph_hi = ph + 1; hipLaunchKernelGGL(fwd_kernel, dim3(grid), dim3(NTHREADS), LDS_BYTES, stream, p); }
#endif
}
```

```cpp
#include <hip/hip_runtime.h>
#include <hip/hip_cooperative_groups.h>
#include <cstdio>
#include <cstdint>
#include <cmath>
namespace cg = cooperative_groups;
namespace pg8 {
#define PG8_LAS __attribute__((address_space(3)))
typedef unsigned short bf16_t;
typedef short bf16x8 __attribute__((ext_vector_type(8)));
typedef float f32x4 __attribute__((ext_vector_type(4)));
typedef unsigned u32x4 __attribute__((ext_vector_type(4)));
constexpr int BM = 256, BK = 64, HALF = 128, HTB = HALF * BK * 2  , STAGE_BYTES = 8 * HTB, NXCD = 8, WGM = 8;

__host__ __device__ __forceinline__ int lds_byte(int r, int c) { const int st = (r >> 4) * 2 + (c >> 5), rr = r & 15, cc = c & 31, ob = rr * 64 + cc * 2; return st * 1024 + (ob ^ (((ob >> 9) & 1) << 5)); }
__host__ __device__ __forceinline__ void stage_rc(int b, int& R, int& C) { const int st = b / 1024, sb = b % 1024, swz = sb ^ (((sb >> 9) & 1) << 5); R = (st >> 1) * 16 + swz / 64; C = (st & 1) * 32 + (swz % 64) / 2; }
__host__ __device__ __forceinline__ int perm32(int rho) { const int n = rho >> 4, i = rho & 15; return 8 * (i >> 2) + 4 * n + (i & 3); }

struct Unit { int pm, pn; };
struct Gemm { const bf16_t* A; const bf16_t* Bt; int M, N, K; };

struct StaticOrder {
    int nM, nN, nwg, G, c;
    __host__ __device__ void init(int M, int N, int G_, int c_) { nM = M / BM; nN = N / BM; nwg = nM * nN; G = G_; c = c_; }
    __host__ __device__ bool next(int i, Unit& u) const {
        const long L = (long)i * G + c; if (L >= nwg) return false;
        int wgid = (int)L; { const int q = nwg / NXCD, r = nwg % NXCD, xcd = wgid % NXCD, off = wgid / NXCD; wgid = (xcd < r ? xcd * (q + 1) : r * (q + 1) + (xcd - r) * q) + off; }
        const int nig = WGM * nN, gid = wgid / nig, fm = gid * WGM, gsz = (nM - fm) < WGM ? (nM - fm) : WGM;
        u.pm = fm + ((wgid % nig) % gsz); u.pn = (wgid % nig) / gsz; return true;
    }
    __device__ __forceinline__ void a_ready(const Unit&) const {}
    __device__ __forceinline__ void done(const Unit&) const {}
};

__device__ __forceinline__ unsigned cvt_pk_bf16(float lo, float hi) { unsigned r; asm volatile("v_cvt_pk_bf16_f32 %0, %1, %2" : "=v"(r) : "v"(lo), "v"(hi)); return r; }
typedef float f32x2 __attribute__((ext_vector_type(2)));
typedef unsigned u32x4 __attribute__((ext_vector_type(4)));
__device__ __forceinline__ float sigmoidf_fast(float x) { return __builtin_amdgcn_rcpf(1.0f + __builtin_amdgcn_exp2f(-1.4426950408889634f * x)); }
struct EpiBf16 {
    static constexpr bool PERM = true, AFTER_DRAIN = false;
    bf16_t* O; int ldc;
    __device__ __forceinline__ void operator()(const f32x4 (&acc)[2][2][4][2], const Unit& u, int wr, int wc, int fr, int fq) const {
        const int row0 = u.pm * BM + wr * 64 + fr; const int col0 = u.pn * BM + wc * 32 + 8 * fq;
#pragma unroll
        for (int ai = 0; ai < 2; ++ai)
#pragma unroll
            for (int m = 0; m < 4; ++m) { bf16_t* rowp = O + (size_t)(row0 + ai * HALF + m * 16) * ldc + col0;
#pragma unroll
                for (int bj = 0; bj < 2; ++bj) { const f32x4 v0 = acc[ai][bj][m][0], v1 = acc[ai][bj][m][1];
                    u32x4 w; w.x = cvt_pk_bf16(v0[0], v0[1]); w.y = cvt_pk_bf16(v0[2], v0[3]); w.z = cvt_pk_bf16(v1[0], v1[1]); w.w = cvt_pk_bf16(v1[2], v1[3]);
                    *(u32x4*)(rowp + bj * HALF) = w; } }
    }
};
struct EpiAct {
    static constexpr bool PERM = true, AFTER_DRAIN = false;
    bf16_t* O; int ldc; int mode;
    __device__ __forceinline__ void operator()(const f32x4 (&acc)[2][2][4][2], const Unit& u, int wr, int wc, int fr, int fq) const {
        const int row0 = u.pm * BM + wr * 64 + fr; const int col0 = u.pn * HALF + wc * 32 + 8 * fq;
#pragma unroll
        for (int ai = 0; ai < 2; ++ai)
#pragma unroll
            for (int m = 0; m < 4; ++m) { bf16_t* rowp = O + (size_t)(row0 + ai * HALF + m * 16) * ldc + col0;
                float r[8];
#pragma unroll
                for (int n = 0; n < 2; ++n)
#pragma unroll
                    for (int e = 0; e < 4; ++e) { const float a = acc[ai][0][m][n][e], b = acc[ai][1][m][n][e];
                        const float s = sigmoidf_fast(mode ? b : a); r[4 * n + e] = mode ? a * s : a * s * b; }
                u32x4 w; w.x = cvt_pk_bf16(r[0], r[1]); w.y = cvt_pk_bf16(r[2], r[3]); w.z = cvt_pk_bf16(r[4], r[5]); w.w = cvt_pk_bf16(r[6], r[7]);
                *(u32x4*)rowp = w; }
    }
};
struct EpiRes {
    static constexpr bool PERM = false, AFTER_DRAIN = false;
    const float* base; float* out; int ldc; float alpha, scale;
    __device__ __forceinline__ void operator()(const f32x4 (&acc)[2][2][4][2], const Unit& u, int wr, int wc, int fr, int fq) const {
        const int col0 = u.pn * BM + wc * 32 + 4 * fq;
#pragma unroll
        for (int ai = 0; ai < 2; ++ai)
#pragma unroll
            for (int m = 0; m < 4; ++m) { const int r = u.pm * BM + ai * HALF + wr * 64 + m * 16 + fr; const size_t off = (size_t)r * ldc + col0;
#pragma unroll
                for (int bj = 0; bj < 2; ++bj)
#pragma unroll
                    for (int n = 0; n < 2; ++n) { const f32x4 bs = *(const f32x4*)(base + off + bj * HALF + n * 16);
                        *(f32x4*)(out + off + bj * HALF + n * 16) = bs * alpha + acc[ai][bj][m][n] * scale; } }
    }
};
template <class Epi, class Sched, bool ALIGN_EPI = false, bool SP2 = false>
__device__ __forceinline__ void gemm_phase(PG8_LAS unsigned char* lds, const Gemm g, const Sched& S, const Epi& E) {
    int tid_ = threadIdx.x; asm volatile("" : "+v"(tid_));
    const int tid = tid_, wid = __builtin_amdgcn_readfirstlane(tid >> 6), lane = tid & 63, wr = wid >> 2, wc = wid & 3, fr = lane & 15, fq = lane >> 4;
    const int K = g.K, nt = K / BK;
    unsigned voffA[2], voffB[2];
#pragma unroll
    for (int i = 0; i < 2; ++i) { int R, C; stage_rc(tid * 16 + i * 8192, R, C); const int Rb = Epi::PERM ? ((R & ~31) + perm32(R & 31)) : R;
        voffA[i] = (unsigned)(R * K + C) * 2u; voffB[i] = (unsigned)(Rb * K + C) * 2u; }
    const size_t kstep = (size_t)(BK * 2);
    const size_t hstep = (size_t)HALF * K * 2;
    const size_t tstep = 2 * hstep;
    const unsigned ldsw = (unsigned)wid * 1024u;
    const int aoff = lds_byte(wr * 64 + fr, fq * 8), boff = lds_byte(wc * 32 + fr, fq * 8);
#define PG8_SA(b, h) (((b) * 2 + (h)) * HTB)
#define PG8_SB(b, h) ((4 + (b) * 2 + (h)) * HTB)
#define PG8_STAGE(bufoff, gbase, voff) do { _Pragma("unroll") for (int _i = 0; _i < 2; ++_i) \
        __builtin_amdgcn_global_load_lds((const unsigned*)((const char*)(gbase) + (voff)[_i]), (PG8_LAS unsigned*)(lds + (bufoff) + ldsw + _i * 8192), 16, 0, 0); } while (0)
#define PG8_LDA(dst, b, h) do { _Pragma("unroll") for (int m = 0; m < 4; ++m) _Pragma("unroll") for (int k = 0; k < 2; ++k) dst[m][k] = *(const PG8_LAS bf16x8*)(lds + PG8_SA(b, h) + aoff + m * 2048 + k * 1024); } while (0)
#define PG8_LDB(dst, b, h) do { _Pragma("unroll") for (int n = 0; n < 2; ++n) _Pragma("unroll") for (int k = 0; k < 2; ++k) dst[n][k] = *(const PG8_LAS bf16x8*)(lds + PG8_SB(b, h) + boff + n * 2048 + k * 1024); } while (0)
#define PG8_MMA(ai, bj, At, Bt) do { __builtin_amdgcn_s_setprio(1); _Pragma("unroll") for (int m = 0; m < 4; ++m) _Pragma("unroll") for (int n = 0; n < 2; ++n) _Pragma("unroll") for (int k = 0; k < 2; ++k) \
        acc[ai][bj][m][n] = __builtin_amdgcn_mfma_f32_16x16x32_bf16(Bt[n][k], At[m][k], acc[ai][bj][m][n], 0, 0, 0); __builtin_amdgcn_s_setprio(0); } while (0)
#define PG8_WAIT_V(n) asm volatile("s_waitcnt vmcnt(" #n ")" ::: "memory")
#define PG8_WAIT_L(n) asm volatile("s_waitcnt lgkmcnt(" #n ")" ::: "memory")
#define PG8_BAR __builtin_amdgcn_s_barrier()
#define PG8_SCHED __builtin_amdgcn_sched_barrier(0)
    Unit cur, nxt; int ui = 0;
    if (!S.next(0, cur)) return;
    f32x4 acc[2][2][4][2];
#pragma unroll
    for (int a = 0; a < 2; ++a)
#pragma unroll
        for (int b = 0; b < 2; ++b)
#pragma unroll
            for (int m = 0; m < 4; ++m)
#pragma unroll
                for (int n = 0; n < 2; ++n) acc[a][b][m][n] = (f32x4){0.f, 0.f, 0.f, 0.f};
    bf16x8 At[4][2], B0[2][2], B1[2][2];
    const char* cA = (const char*)g.A + (size_t)cur.pm * tstep; const char* cB = (const char*)g.Bt + (size_t)cur.pn * tstep;
    S.a_ready(cur);
    if constexpr (SP2) {
        PG8_STAGE(PG8_SB(0, 0), cB, voffB); PG8_STAGE(PG8_SB(0, 1), cB + hstep, voffB); PG8_STAGE(PG8_SA(0, 0), cA, voffA); PG8_STAGE(PG8_SA(0, 1), cA + hstep, voffA);
        if (wr == 1) PG8_BAR;
        PG8_WAIT_V(2); PG8_BAR;
        PG8_STAGE(PG8_SB(1, 0), cB + kstep, voffB); PG8_STAGE(PG8_SA(1, 0), cA + kstep, voffA); PG8_STAGE(PG8_SB(1, 1), cB + hstep + kstep, voffB);
        PG8_WAIT_V(6); PG8_BAR;
    } else {
        PG8_STAGE(PG8_SB(0, 0), cB, voffB); PG8_STAGE(PG8_SA(0, 0), cA, voffA); PG8_STAGE(PG8_SB(0, 1), cB + hstep, voffB); PG8_STAGE(PG8_SA(0, 1), cA + hstep, voffA);
        if (wr == 1) PG8_BAR;
        PG8_WAIT_V(4); PG8_BAR;
        PG8_STAGE(PG8_SB(1, 0), cB + kstep, voffB); PG8_STAGE(PG8_SA(1, 0), cA + kstep, voffA); PG8_STAGE(PG8_SB(1, 1), cB + hstep + kstep, voffB);
        PG8_WAIT_V(6); PG8_BAR;
    }
    for (;;) {
        const bool has_next = S.next(ui + 1, nxt);
        const char* nA = has_next ? (const char*)g.A + (size_t)nxt.pm * tstep : cA; const char* nB = has_next ? (const char*)g.Bt + (size_t)nxt.pn * tstep : cB;
        for (int t = 0; t < nt; t += 2) {
            const bool last = (t == nt - 2);
            const char* a1 = cA + (size_t)(t + 1) * kstep;
            const char* a2 = last ? nA : cA + (size_t)(t + 2) * kstep; const char* b2 = last ? nB : cB + (size_t)(t + 2) * kstep;
            const char* a3 = a2 + kstep; const char* b3 = b2 + kstep;
            if (last && has_next) S.a_ready(nxt);
            if constexpr (SP2) {
            PG8_LDB(B0, 0, 0); PG8_LDB(B1, 0, 1); PG8_SCHED; PG8_LDA(At, 0, 0); PG8_STAGE(PG8_SA(1, 1), a1 + hstep, voffA);
            PG8_WAIT_V(8); PG8_WAIT_L(0); PG8_BAR; PG8_MMA(0, 0, At, B0); PG8_MMA(0, 1, At, B1); PG8_BAR; PG8_SCHED;
            PG8_LDA(At, 0, 1); PG8_STAGE(PG8_SB(0, 0), b2, voffB); PG8_STAGE(PG8_SB(0, 1), b2 + hstep, voffB); PG8_STAGE(PG8_SA(0, 0), a2, voffA);
            PG8_WAIT_V(8); PG8_WAIT_L(0); PG8_BAR; PG8_MMA(1, 0, At, B0); PG8_MMA(1, 1, At, B1); PG8_BAR; PG8_SCHED;
            PG8_LDB(B0, 1, 0); PG8_LDB(B1, 1, 1); PG8_SCHED; PG8_LDA(At, 1, 0); PG8_STAGE(PG8_SA(0, 1), a2 + hstep, voffA);
            PG8_WAIT_V(8); PG8_WAIT_L(0); PG8_BAR; PG8_MMA(0, 0, At, B0); PG8_MMA(0, 1, At, B1); PG8_BAR; PG8_SCHED;
            PG8_LDA(At, 1, 1); PG8_STAGE(PG8_SB(1, 0), b3, voffB); PG8_STAGE(PG8_SB(1, 1), b3 + hstep, voffB); PG8_STAGE(PG8_SA(1, 0), a3, voffA);
            PG8_WAIT_V(8); PG8_WAIT_L(0); PG8_BAR; PG8_MMA(1, 0, At, B0); PG8_MMA(1, 1, At, B1); PG8_BAR; PG8_SCHED;
            } else {
            PG8_LDB(B0, 0, 0); PG8_SCHED; PG8_LDA(At, 0, 0); PG8_STAGE(PG8_SA(1, 1), a1 + hstep, voffA);
            PG8_WAIT_L(8); PG8_BAR; PG8_WAIT_L(0); PG8_MMA(0, 0, At, B0); PG8_BAR; PG8_SCHED;
            PG8_LDB(B1, 0, 1); PG8_STAGE(PG8_SB(0, 0), b2, voffB);
            PG8_BAR; PG8_WAIT_L(0); PG8_MMA(0, 1, At, B1); PG8_BAR;
            PG8_LDA(At, 0, 1); PG8_STAGE(PG8_SA(0, 0), a2, voffA);
            PG8_BAR; PG8_WAIT_L(0); PG8_MMA(1, 0, At, B0); PG8_BAR; PG8_SCHED;
            PG8_STAGE(PG8_SB(0, 1), b2 + hstep, voffB);
            PG8_WAIT_V(6); PG8_BAR; PG8_MMA(1, 1, At, B1); PG8_BAR;
            PG8_LDB(B0, 1, 0); PG8_SCHED; PG8_LDA(At, 1, 0); PG8_STAGE(PG8_SA(0, 1), a2 + hstep, voffA);
            PG8_WAIT_L(8); PG8_BAR; PG8_WAIT_L(0); PG8_MMA(0, 0, At, B0); PG8_BAR; PG8_SCHED;
            PG8_LDB(B1, 1, 1); PG8_STAGE(PG8_SB(1, 0), b3, voffB);
            PG8_BAR; PG8_WAIT_L(0); PG8_MMA(0, 1, At, B1); PG8_BAR;
            PG8_LDA(At, 1, 1); PG8_STAGE(PG8_SA(1, 0), a3, voffA);
            PG8_BAR; PG8_WAIT_L(0); PG8_MMA(1, 0, At, B0); PG8_BAR; PG8_SCHED;
            PG8_STAGE(PG8_SB(1, 1), b3 + hstep, voffB);
            PG8_WAIT_V(6); PG8_BAR; PG8_MMA(1, 1, At, B1); PG8_BAR;
            }
        }
        if constexpr (ALIGN_EPI) { if (wr == 0) PG8_BAR; }
        if constexpr (!Epi::AFTER_DRAIN) { E(acc, cur, wr, wc, fr, fq); S.done(cur); }
        if (!has_next) break;
#pragma unroll
        for (int a = 0; a < 2; ++a)
#pragma unroll
            for (int b = 0; b < 2; ++b)
#pragma unroll
                for (int m = 0; m < 4; ++m)
#pragma unroll
                    for (int n = 0; n < 2; ++n) acc[a][b][m][n] = (f32x4){0.f, 0.f, 0.f, 0.f};
        cur = nxt; cA = nA; cB = nB; ++ui;
        if constexpr (ALIGN_EPI) { if (wr == 1) PG8_BAR; }
    }
    PG8_WAIT_V(0);
    if constexpr (!ALIGN_EPI) { if (wr == 0) PG8_BAR; }
    PG8_BAR;
    if constexpr (Epi::AFTER_DRAIN) { E.fused(acc, cur, wr, wc, fr, fq, lds, wid, lane); S.done(cur); }
#undef PG8_SA
#undef PG8_SB
#undef PG8_STAGE
#undef PG8_LDA
#undef PG8_LDB
#undef PG8_MMA
#undef PG8_WAIT_V
#undef PG8_WAIT_L
#undef PG8_BAR
#undef PG8_SCHED
}
}
#ifndef DUP_DIFF
#define DUP_DIFF 1
#endif
#ifndef DUP_DSA
#define DUP_DSA 1
#endif
#ifndef DUP_ATTB
#define DUP_ATTB 1
#endif
#ifndef DUP_PH
#define DUP_PH 0
#endif
#ifndef DUP_SYNC
#define DUP_SYNC 0
#endif
#ifndef DUP_PRO
#define DUP_PRO 1
#endif
#ifndef DUP_CONV
#define DUP_CONV 1
#endif
#ifndef SEL_A
#define SEL_A 64
#endif
#ifndef EN_MASK
#define EN_MASK 0xffff
#endif
#define EN_PRO ((EN_MASK) & 1)
#define EN_GEMM1 ((EN_MASK) & 2)
#define EN_GEMM2 ((EN_MASK) & 4)
#define EN_GEMM3 ((EN_MASK) & 8)
#define EN_LN ((EN_MASK) & 16)
#define EN_IKLN ((EN_MASK) & 32)
#define EN_CONV ((EN_MASK) & 64)
#define EN_DIFF ((EN_MASK) & 128)
#define EN_DSA ((EN_MASK) & 256)
constexpr int SEQ = 8192, NB = 2, MTOK = NB * SEQ, DM = 1024, DFF = 2816, DEPTH = 4;
constexpr int PW = 3840;
constexpr int COL_QA = 0, COL_KA = 512, COL_VA = 1024, COL_IQ = 1536, COL_QB = 2048, COL_KB = 2560, COL_VB = 3072, COL_IK = 3584, COL_IW = 3648;
constexpr int PMIX = 3656;
constexpr float LN_EPS = 1e-5f;
constexpr float ALPHA = 1.6817928305074290f;
constexpr float LOG2E = 1.4426950408889634f;
constexpr int NTHREADS = 512, NWAVES = 8;
constexpr size_t MiB = 1u << 20;
constexpr size_t WS_WFI = 0, SZ_WFI = 11 * MiB;
constexpr size_t WS_WFO = 88 * MiB, SZ_WFO = 5632 * 1024;
constexpr size_t WS_WMI = 132 * MiB, SZ_WMI = (size_t)PW * 1024 * 2;
constexpr size_t WS_WMO = 147 * MiB, SZ_WMO = 2 * MiB;
constexpr size_t WS_WCI = 151 * MiB, SZ_WCI = 4 * MiB;
constexpr size_t WS_WCO = 159 * MiB, SZ_WCO = 2 * MiB;
constexpr size_t WS_XB = 164 * MiB;
constexpr size_t WS_PB = 196 * MiB;
constexpr size_t WS_Y = 316 * MiB;
constexpr size_t WS_SCR = 380 * MiB;
constexpr size_t WS_IK = 508 * MiB;
constexpr size_t WS_BITS = 510 * MiB;
constexpr size_t WS_CTL = 526 * MiB, CTL_BYTES = 65536;
constexpr size_t WS_END = 527 * MiB;
constexpr int LDS_BYTES = 131072 + 8192;
constexpr int LDS_LUT = 131072;

typedef unsigned short bf16;
typedef short bf16x8 __attribute__((ext_vector_type(8)));
typedef short s16x4 __attribute__((ext_vector_type(4)));
typedef float f32x4 __attribute__((ext_vector_type(4)));
typedef float f32x16 __attribute__((ext_vector_type(16)));
typedef unsigned u32x4 __attribute__((ext_vector_type(4)));
typedef unsigned u32x2 __attribute__((ext_vector_type(2)));
#define LAS __attribute__((address_space(3)))

__device__ __forceinline__ unsigned f2bf(float f) { unsigned u = __builtin_bit_cast(unsigned, f); return (u + 0x7fffu + ((u >> 16) & 1u)) >> 16; }
__device__ __forceinline__ unsigned pk2(float lo, float hi) { return f2bf(lo) | (f2bf(hi) << 16); }
__device__ __forceinline__ float bflo(unsigned w) { return __builtin_bit_cast(float, w << 16); }
__device__ __forceinline__ float bfhi(unsigned w) { return __builtin_bit_cast(float, w & 0xffff0000u); }
__device__ __forceinline__ float wave_sum(float v) {
#pragma unroll
    for (int o = 1; o < 64; o <<= 1) v += __shfl_xor(v, o);
    return v;
}
__device__ __forceinline__ int launder_tid() { int t = threadIdx.x; asm volatile("" : "+v"(t)); return t; }
__device__ __forceinline__ int wave_sum_i(int v) {
    v += __builtin_amdgcn_update_dpp(0, v, 0xB1, 0xf, 0xf, false);
    v += __builtin_amdgcn_update_dpp(0, v, 0x4E, 0xf, 0xf, false);
    v += __builtin_amdgcn_update_dpp(0, v, 0x141, 0xf, 0xf, false);
    v += __builtin_amdgcn_update_dpp(0, v, 0x140, 0xf, 0xf, false);
    return __builtin_amdgcn_readlane(v, 0) + __builtin_amdgcn_readlane(v, 16) + __builtin_amdgcn_readlane(v, 32) + __builtin_amdgcn_readlane(v, 48);
}
__device__ __forceinline__ int crow(int r, int hi) { return (r & 3) + 8 * (r >> 2) + 4 * hi; }

struct Params { const float* in[18]; float* out; unsigned char* ws; int ph_lo, ph_hi; };

__device__ __forceinline__ int dest_row(int n, int mode, int NH) {
    if (mode == 0) return n;
    if (mode == 1) { const int hf = n >= NH ? 1 : 0, nn = n - hf * NH; return (nn >> 7) * 256 + hf * 128 + (nn & 127); }
    if (n < 2048) return n;
    if (n < 2112) return COL_IK + (n - 2048);
    if (n < 2120) return COL_IW + (n - 2112);
    return COL_QB + (n - 2120);
}
__device__ __forceinline__ void transpose_item(const float* W, int K, int N, bf16* WT, int mode, LAS float* scr, int item, int lane) {
    const int nblk = (N + 31) / 32, kb = item / nblk, nb = item % nblk, k0 = 64 * kb, n0 = 32 * nb;
    const int nr = n0 + (lane & 31);
#pragma unroll 8
    for (int i = 0; i < 32; ++i) { const int kk = 2 * i + (lane >> 5); scr[kk * 33 + (lane & 31)] = nr < N ? W[(size_t)(k0 + kk) * N + nr] : 0.f; }
    asm volatile("s_waitcnt lgkmcnt(0)" ::: "memory");
    const int c = lane & 7;
#pragma unroll
    for (int j = 0; j < 4; ++j) { const int n = (lane >> 3) + 8 * j; const LAS float* s = scr + (8 * c) * 33 + n;
        u32x4 o; o.x = pk2(s[0 * 33], s[1 * 33]); o.y = pk2(s[2 * 33], s[3 * 33]); o.z = pk2(s[4 * 33], s[5 * 33]); o.w = pk2(s[6 * 33], s[7 * 33]);
        if (n0 + n < N) *(u32x4*)(WT + (size_t)dest_row(n0 + n, mode, N / 2) * K + k0 + 8 * c) = o; }
    asm volatile("s_waitcnt lgkmcnt(0)" ::: "memory");
}
__device__ __forceinline__ void prologue_phase(const Params& p, unsigned char* lds) {
    const int tid = launder_tid(), lane = tid & 63, wave = __builtin_amdgcn_readfirstlane(tid >> 6);
    LAS float* scr = (LAS float*)((LAS unsigned char*)lds + wave * 16384);
    const int gw = blockIdx.x * NWAVES + wave, NGW = gridDim.x * NWAVES;
    unsigned char* ws = p.ws;
    constexpr int I_FI = (1024 / 64) * (5632 / 32), I_FO = (2816 / 64) * (1024 / 32), I_MI = (1024 / 64) * ((PMIX + 31) / 32), I_SQ = (1024 / 64) * (1024 / 32), I_CI = (1024 / 64) * (2048 / 32);
    constexpr int T_FI = 8 * I_FI, T_FO = 8 * I_FO, T_MI = 2 * I_MI, T_MO = 2 * I_SQ, T_CI = 2 * I_CI, T_CO = 2 * I_SQ;
    constexpr int NITEMS = T_FI + T_FO + T_MI + T_MO + T_CI + T_CO;
    for (int it = gw; it < NITEMS; it += NGW) {
        int r = it;
        if (r < T_FI) { const int w = r / I_FI; transpose_item(p.in[1] + (size_t)w * 1024 * 5632, 1024, 5632, (bf16*)(ws + WS_WFI + w * SZ_WFI), 1, scr, r % I_FI, lane); continue; } r -= T_FI;
        if (r < T_FO) { const int w = r / I_FO; transpose_item(p.in[2] + (size_t)w * 2816 * 1024, 2816, 1024, (bf16*)(ws + WS_WFO + w * SZ_WFO), 0, scr, r % I_FO, lane); continue; } r -= T_FO;
        if (r < T_MI) { const int w = r / I_MI; transpose_item(p.in[6] + (size_t)w * 1024 * PMIX, 1024, PMIX, (bf16*)(ws + WS_WMI + w * SZ_WMI), 2, scr, r % I_MI, lane); continue; } r -= T_MI;
        if (r < T_MO) { const int w = r / I_SQ; transpose_item(p.in[11] + (size_t)w * 1024 * 1024, 1024, 1024, (bf16*)(ws + WS_WMO + w * SZ_WMO), 0, scr, r % I_SQ, lane); continue; } r -= T_MO;
        if (r < T_CI) { const int w = r / I_CI; transpose_item(p.in[12] + (size_t)w * 1024 * 2048, 1024, 2048, (bf16*)(ws + WS_WCI + w * SZ_WCI), 1, scr, r % I_CI, lane); continue; } r -= T_CI;
        { const int w = r / I_SQ; transpose_item(p.in[17] + (size_t)w * 1024 * 1024, 1024, 1024, (bf16*)(ws + WS_WCO + w * SZ_WCO), 0, scr, r % I_SQ, lane); }
    }
    const float* x = p.in[0]; bf16* xb = (bf16*)(ws + WS_XB);
    for (int m = gw; m < MTOK; m += NGW) {
        const f32x4* xr = (const f32x4*)(x + (size_t)m * DM) + lane; u32x2* o = (u32x2*)(xb + (size_t)m * DM) + lane;
#pragma unroll
        for (int j = 0; j < 4; ++j) { const f32x4 v = xr[64 * j]; u32x2 w; w.x = pk2(v.x, v.y); w.y = pk2(v.z, v.w); o[64 * j] = w; }
    }
}
__device__ __forceinline__ void ln_phase(const float* Y, const float* g, const float* bta, float* X, bf16* XB) {
    const int tid = launder_tid(), lane = tid & 63, wave = __builtin_amdgcn_readfirstlane(tid >> 6);
    const int gw = blockIdx.x * NWAVES + wave, NGW = gridDim.x * NWAVES;
    f32x4 gv[4], bv[4];
#pragma unroll
    for (int j = 0; j < 4; ++j) { gv[j] = ((const f32x4*)g)[lane + 64 * j]; bv[j] = ((const f32x4*)bta)[lane + 64 * j]; }
    for (int m = gw; m < MTOK; m += NGW) {
        const f32x4* yr = (const f32x4*)(Y + (size_t)m * DM) + lane;
        f32x4 v[4]; float s = 0.f;
#pragma unroll
        for (int j = 0; j < 4; ++j) { v[j] = yr[64 * j]; s += (v[j].x + v[j].y) + (v[j].z + v[j].w); }
        const float mean = wave_sum(s) * (1.f / DM); float s2 = 0.f;
#pragma unroll
        for (int j = 0; j < 4; ++j) { v[j] = v[j] - mean; s2 += (v[j].x * v[j].x + v[j].y * v[j].y) + (v[j].z * v[j].z + v[j].w * v[j].w); }
        const float rstd = 1.0f / sqrtf(wave_sum(s2) * (1.f / DM) + LN_EPS);
        f32x4* xo = (f32x4*)(X + (size_t)m * DM) + lane; u32x2* bo = (u32x2*)(XB + (size_t)m * DM) + lane;
#pragma unroll
        for (int j = 0; j < 4; ++j) { const f32x4 o = v[j] * rstd * gv[j] + bv[j]; xo[64 * j] = o; u32x2 w; w.x = pk2(o.x, o.y); w.y = pk2(o.z, o.w); bo[64 * j] = w; }
    }
}
__device__ __forceinline__ void ikln_phase(const bf16* P, const float* g, const float* bta, bf16* IK) {
    const int gt = blockIdx.x * NTHREADS + launder_tid(), NT = gridDim.x * NTHREADS;
    for (int m = gt; m < MTOK; m += NT) {
        const u32x4* src = (const u32x4*)(P + (size_t)m * PW + COL_IK);
        float v[64]; float s = 0.f;
#pragma unroll
        for (int c = 0; c < 8; ++c) { const u32x4 w = src[c];
            v[8 * c + 0] = bflo(w.x); v[8 * c + 1] = bfhi(w.x); v[8 * c + 2] = bflo(w.y); v[8 * c + 3] = bfhi(w.y);
            v[8 * c + 4] = bflo(w.z); v[8 * c + 5] = bfhi(w.z); v[8 * c + 6] = bflo(w.w); v[8 * c + 7] = bfhi(w.w); }
#pragma unroll
        for (int i = 0; i < 64; ++i) s += v[i];
        const float mean = s * (1.f / 64.f); float s2 = 0.f;
#pragma unroll
        for (int i = 0; i < 64; ++i) { v[i] -= mean; s2 += v[i] * v[i]; }
        const float rstd = 1.0f / sqrtf(s2 * (1.f / 64.f) + LN_EPS);
        u32x4* dst = (u32x4*)(IK + (size_t)m * 64);
#pragma unroll
        for (int c = 0; c < 8; ++c) { u32x4 w;
            w.x = pk2(v[8 * c + 0] * rstd * g[8 * c + 0] + bta[8 * c + 0], v[8 * c + 1] * rstd * g[8 * c + 1] + bta[8 * c + 1]);
            w.y = pk2(v[8 * c + 2] * rstd * g[8 * c + 2] + bta[8 * c + 2], v[8 * c + 3] * rstd * g[8 * c + 3] + bta[8 * c + 3]);
            w.z = pk2(v[8 * c + 4] * rstd * g[8 * c + 4] + bta[8 * c + 4], v[8 * c + 5] * rstd * g[8 * c + 5] + bta[8 * c + 5]);
            w.w = pk2(v[8 * c + 6] * rstd * g[8 * c + 6] + bta[8 * c + 6], v[8 * c + 7] * rstd * g[8 * c + 7] + bta[8 * c + 7]);
            dst[c] = w; }
    }
}
__device__ __forceinline__ void conv_phase(const bf16* U, const float* dw, const float* dwb, const float* g, const float* bta, bf16* V) {
    const int tid = launder_tid(), lane = tid & 63, wave = __builtin_amdgcn_readfirstlane(tid >> 6);
    const int gw = blockIdx.x * NWAVES + wave, NGW = gridDim.x * NWAVES;
    for (int m = gw; m < MTOK; m += NGW) {
        const int t = m & (SEQ - 1);
        float acc[16];
#pragma unroll
        for (int jj = 0; jj < 2; ++jj) { const int c0 = lane * 8 + 512 * jj; const f32x4 b0 = *(const f32x4*)(dwb + c0), b1 = *(const f32x4*)(dwb + c0 + 4);
            acc[8 * jj + 0] = b0.x; acc[8 * jj + 1] = b0.y; acc[8 * jj + 2] = b0.z; acc[8 * jj + 3] = b0.w; acc[8 * jj + 4] = b1.x; acc[8 * jj + 5] = b1.y; acc[8 * jj + 6] = b1.z; acc[8 * jj + 7] = b1.w; }
        const int j0 = t >= 30 ? 0 : 30 - t;
        for (int j = j0; j < 31; ++j) {
            const bf16* urow = U + (size_t)(m - 30 + j) * DM; const float* wrow = dw + (size_t)j * DM;
#pragma unroll
            for (int jj = 0; jj < 2; ++jj) { const int c0 = lane * 8 + 512 * jj; const u32x4 u = *(const u32x4*)(urow + c0); const f32x4 w0 = *(const f32x4*)(wrow + c0), w1 = *(const f32x4*)(wrow + c0 + 4);
                acc[8 * jj + 0] += bflo(u.x) * w0.x; acc[8 * jj + 1] += bfhi(u.x) * w0.y; acc[8 * jj + 2] += bflo(u.y) * w0.z; acc[8 * jj + 3] += bfhi(u.y) * w0.w;
                acc[8 * jj + 4] += bflo(u.z) * w1.x; acc[8 * jj + 5] += bfhi(u.z) * w1.y; acc[8 * jj + 6] += bflo(u.w) * w1.z; acc[8 * jj + 7] += bfhi(u.w) * w1.w; }
        }
        float s = 0.f;
#pragma unroll
        for (int i = 0; i < 16; ++i) s += acc[i];
        const float mean = wave_sum(s) * (1.f / DM); float s2 = 0.f;
#pragma unroll
        for (int i = 0; i < 16; ++i) { acc[i] -= mean; s2 += acc[i] * acc[i]; }
        const float rstd = 1.0f / sqrtf(wave_sum(s2) * (1.f / DM) + LN_EPS);
#pragma unroll
        for (int jj = 0; jj < 2; ++jj) { const int c0 = lane * 8 + 512 * jj; float o[8];
#pragma unroll
            for (int e = 0; e < 8; ++e) { const float y = acc[8 * jj + e] * rstd * g[c0 + e] + bta[c0 + e]; o[e] = y * pg8::sigmoidf_fast(y); }
            u32x4 w; w.x = pk2(o[0], o[1]); w.y = pk2(o[2], o[3]); w.z = pk2(o[4], o[5]); w.w = pk2(o[6], o[7]);
            *(u32x4*)(V + (size_t)m * DM + c0) = w; }
    }
}
__device__ __forceinline__ int t5_bucket(int n) {
    if (n < 16) return n;
    int v = 16 + (int)(logf((float)n / 16.0f) / logf(8.0f) * 16.0f);
    return v < 31 ? v : 31;
}
__device__ __forceinline__ unsigned cvtpk(float lo, float hi) { typedef float f2 __attribute__((ext_vector_type(2))); typedef __bf16 b2 __attribute__((ext_vector_type(2))); f2 v = {lo, hi}; b2 b = __builtin_convertvector(v, b2); return __builtin_bit_cast(unsigned, b); }
__device__ __forceinline__ bf16x8 pack8(const f32x16& x, int s) {
    u32x4 p; p.x = cvtpk(x[8 * s + 0], x[8 * s + 1]); p.y = cvtpk(x[8 * s + 2], x[8 * s + 3]); p.z = cvtpk(x[8 * s + 4], x[8 * s + 5]); p.w = cvtpk(x[8 * s + 6], x[8 * s + 7]);
    return __builtin_bit_cast(bf16x8, p);
}
typedef short v4i16_t __attribute__((ext_vector_type(4)));
__device__ __forceinline__ s16x4 vtr(const LAS unsigned char* p) { return __builtin_bit_cast(s16x4, __builtin_amdgcn_ds_read_tr16_b64_v4i16((LAS v4i16_t*)p)); }

__device__ __forceinline__ void diff_unit(unsigned char* ldsg, const bf16* P, bf16* O, int b, int h, int qb, float lam_full, float oscale, const float* subg) {
    LAS unsigned char* lds = (LAS unsigned char*)ldsg;
    const int tid = launder_tid(), lane = tid & 63, wid = __builtin_amdgcn_readfirstlane(tid >> 6), r32 = lane & 31, hi = lane >> 5;
    const int map = wid >> 2, qs = wid & 3;
    const int q0 = qb * 128, qmin = q0 + qs * 32, myq = qmin + r32;
    const size_t rowbase = (size_t)b * SEQ;
    constexpr int RS = 272, TILE = 64 * RS;
    LAS float* wsf = (LAS float*)(lds + 4 * TILE) + wid * 32;
    const LAS float* lut = (const LAS float*)(lds + LDS_LUT) + (8 + h) * 129;
    bf16x8 qr[4];
    { const bf16* qp = P + (rowbase + myq) * PW + COL_QB + h * 128 + map * 64 + hi * 8;
#pragma unroll
      for (int d0 = 0; d0 < 4; ++d0) qr[d0] = *(const bf16x8*)(qp + d0 * 16); }
    const int NT = 2 * qb + 2;
    f32x16 o[4];
#pragma unroll
    for (int d = 0; d < 4; ++d)
#pragma unroll
        for (int i = 0; i < 16; ++i) o[d][i] = 0.f;
    float mrun = -INFINITY, lrun = 0.f;
    const float SC = 0.125f * LOG2E;
    const int lrow0 = tid >> 4, lc16 = tid & 15;
    const bf16* kg = P + (rowbase + lrow0) * PW + COL_KB + h * 128 + lc16 * 8;
    const bf16* vg = P + (rowbase + lrow0) * PW + COL_VB + h * 128 + lc16 * 8;
    u32x4 kr[2], vr[2];
#pragma unroll
    for (int i = 0; i < 2; ++i) { kr[i] = *(const u32x4*)(kg + (size_t)(32 * i) * PW); vr[i] = *(const u32x4*)(vg + (size_t)(32 * i) * PW); }
    const int q4 = (lane & 15) >> 2;
    const int vcol = (16 * ((lane >> 4) & 1) + 4 * (lane & 3)) * 2;
    for (int t = 0; t < NT; ++t) {
        const int buf = t & 1;
        LAS unsigned char* Kb = lds + buf * TILE; LAS unsigned char* Vb = lds + (2 + buf) * TILE;
#pragma unroll
        for (int i = 0; i < 2; ++i) { *(LAS u32x4*)(Kb + (lrow0 + 32 * i) * RS + lc16 * 16) = kr[i]; *(LAS u32x4*)(Vb + (lrow0 + 32 * i) * RS + lc16 * 16) = vr[i]; }
        __syncthreads();
        if (t + 1 < NT) {
#pragma unroll
            for (int i = 0; i < 2; ++i) { kr[i] = *(const u32x4*)(kg + (size_t)(64 * (t + 1) + 32 * i) * PW); vr[i] = *(const u32x4*)(vg + (size_t)(64 * (t + 1) + 32 * i) * PW); }
        }
        const int kb0 = 64 * t;
        if (kb0 > qmin + 31) continue;
        f32x16 p0, p1;
#pragma unroll
        for (int i = 0; i < 16; ++i) { p0[i] = 0.f; p1[i] = 0.f; }
#pragma unroll
        for (int d0 = 0; d0 < 4; ++d0) {
            const bf16x8 a0 = *(const LAS bf16x8*)(Kb + r32 * RS + (map * 64 + d0 * 16 + hi * 8) * 2);
            const bf16x8 a1 = *(const LAS bf16x8*)(Kb + (32 + r32) * RS + (map * 64 + d0 * 16 + hi * 8) * 2);
            p0 = __builtin_amdgcn_mfma_f32_32x32x16_bf16(a0, qr[d0], p0, 0, 0, 0);
            p1 = __builtin_amdgcn_mfma_f32_32x32x16_bf16(a1, qr[d0], p1, 0, 0, 0);
        }
        if (qmin - (kb0 + 63) >= 128) {
            const float c = lut[128];
#pragma unroll
            for (int i = 0; i < 16; ++i) { p0[i] = p0[i] * SC + c; p1[i] = p1[i] * SC + c; }
        } else {
#pragma unroll
            for (int i = 0; i < 16; ++i) {
                const int n0 = myq - (kb0 + crow(i, hi)), n1 = n0 - 32;
                const float b0 = lut[n0 < 0 ? 0 : (n0 > 128 ? 128 : n0)], b1 = lut[n1 < 0 ? 0 : (n1 > 128 ? 128 : n1)];
                p0[i] = n0 < 0 ? -INFINITY : p0[i] * SC + b0; p1[i] = n1 < 0 ? -INFINITY : p1[i] * SC + b1;
            }
        }
        float rm = fmaxf(p0[0], p1[0]);
#pragma unroll
        for (int i = 1; i < 16; ++i) rm = fmaxf(rm, fmaxf(p0[i], p1[i]));
        rm = fmaxf(rm, __shfl_xor(rm, 32));
        const float mnew = fmaxf(mrun, rm);
        const float f = __builtin_amdgcn_exp2f(mrun - mnew);
        mrun = mnew;
        float ls = 0.f;
#pragma unroll
        for (int i = 0; i < 16; ++i) { p0[i] = __builtin_amdgcn_exp2f(p0[i] - mnew); p1[i] = __builtin_amdgcn_exp2f(p1[i] - mnew); ls += p0[i] + p1[i]; }
        lrun = lrun * f + ls;
        if (__any(f != 1.0f)) {
            if (hi == 0) wsf[r32] = f;
            __builtin_amdgcn_wave_barrier();
#pragma unroll
            for (int i = 0; i < 16; ++i) { const float fi = wsf[crow(i, hi)];
#pragma unroll
                for (int d = 0; d < 4; ++d) o[d][i] *= fi; }
            __builtin_amdgcn_wave_barrier();
        }
        bf16x8 pa[4]; pa[0] = pack8(p0, 0); pa[1] = pack8(p0, 1); pa[2] = pack8(p1, 0); pa[3] = pack8(p1, 1);
#pragma unroll
        for (int d0 = 0; d0 < 4; ++d0)
#pragma unroll
            for (int ks = 0; ks < 4; ++ks) {
                const LAS unsigned char* vp = Vb + (16 * ks + 4 * hi + q4) * RS + d0 * 64 + vcol;
                const s16x4 lo = vtr(vp), hh = vtr(vp + 8 * RS);
                const bf16x8 vf = __builtin_shufflevector(lo, hh, 0, 1, 2, 3, 4, 5, 6, 7);
                o[d0] = __builtin_amdgcn_mfma_f32_32x32x16_bf16(pa[ks], vf, o[d0], 0, 0, 0);
            }
    }
    lrun += __shfl_xor(lrun, 32);
    if (hi == 0) wsf[r32] = 1.0f / lrun;
    __builtin_amdgcn_wave_barrier();
#pragma unroll
    for (int i = 0; i < 16; ++i) { const float fi = wsf[crow(i, hi)];
#pragma unroll
        for (int d = 0; d < 4; ++d) o[d][i] *= fi; }
    __syncthreads();
    LAS float* X = (LAS float*)lds;
    if (map == 1) {
#pragma unroll
        for (int d = 0; d < 4; ++d)
#pragma unroll
            for (int i = 0; i < 16; ++i) X[(qs * 32 + crow(i, hi)) * 128 + 32 * d + r32] = o[d][i];
    }
    __syncthreads();
    if (map == 0) {
        float gsub[4];
#pragma unroll
        for (int d = 0; d < 4; ++d) gsub[d] = subg[32 * d + r32];
#pragma unroll
        for (int i = 0; i < 16; ++i) {
            float ss = 0.f;
#pragma unroll
            for (int d = 0; d < 4; ++d) { const float v = o[d][i] - lam_full * X[(qs * 32 + crow(i, hi)) * 128 + 32 * d + r32]; o[d][i] = v; ss += v * v; }
#pragma unroll
            for (int sft = 1; sft < 32; sft <<= 1) ss += __shfl_xor(ss, sft);
            const float rs = (1.0f / sqrtf(ss * (1.f / 128.f) + LN_EPS)) * oscale;
            bf16* orow = O + (rowbase + qmin + crow(i, hi)) * DM + 512 + h * 128 + r32;
#pragma unroll
            for (int d = 0; d < 4; ++d) orow[32 * d] = (bf16)f2bf(o[d][i] * rs * gsub[d]);
        }
    }
    __syncthreads();
}

__device__ __forceinline__ void cnt_ge2(int& a0, int& a1, unsigned k0, unsigned k1, unsigned c) {
    unsigned long long m;
    asm volatile("v_cmp_ge_u32_e32 vcc, %3, %5\n\tv_cmp_ge_u32_e64 %2, %4, %5\n\ts_nop 0\n\tv_addc_co_u32_e32 %0, vcc, 0, %0, vcc\n\tv_addc_co_u32_e64 %1, %2, 0, %1, %2"
                 : "+v"(a0), "+v"(a1), "=&s"(m) : "v"(k0), "v"(k1), "v"(c) : "vcc");
}
template <int NREG>
__device__ __forceinline__ void select_query(const float* row, int t, int lane, unsigned long long* brow64) {
    unsigned k[NREG];
#pragma unroll
    for (int r = 0; r < NREG; ++r) k[r] = __builtin_bit_cast(unsigned, row[r * 64 + lane]);
#pragma unroll
    for (int r = 0; r < NREG; ++r) {
        const unsigned u = k[r]; unsigned key = u ^ ((unsigned)((int)u >> 31) | 0x80000000u);
        const int tl = t - r * 64;
        if (tl < 63) asm volatile("v_cmp_lt_i32_e32 vcc, %1, %2\n\ts_nop 1\n\tv_cndmask_b32_e64 %0, %0, 0, vcc" : "+v"(key) : "s"(tl), "v"(lane) : "vcc");
        k[r] = key;
    }
    unsigned pth = 1u, ptie = 0u; int need = 0, cgt = 0;
    if (t >= 256) {
        pth = 0u; int cntge = 0;
        for (int bit = 31; bit >= 0; --bit) {
            const unsigned c = pth | (1u << bit);
            int c0 = 0, c1 = 0;
#pragma unroll
            for (int r = 0; r < NREG; r += 2) cnt_ge2(c0, c1, k[r], k[r + 1], c);
            const int cnt = wave_sum_i(c0 + c1);
            if (cnt >= 256) { pth = c; cntge = cnt; }
            if (cnt == 256) break;
        }
        if (cntge != 256) {
            int c0 = 0, c1 = 0;
#pragma unroll
            for (int r = 0; r < NREG; r += 2) cnt_ge2(c0, c1, k[r], k[r + 1], pth + 1u);
            cgt = wave_sum_i(c0 + c1); need = 256 - cgt; ptie = pth; pth = pth + 1u;
        }
    }
    {
        unsigned w0lo = 0u, w0hi = 0u, w1lo = 0u, w1hi = 0u;
#define WL1(r) { if constexpr ((r) < NREG) { const unsigned long long m0 = __ballot(k[(r) < NREG ? (r) : 0] >= pth); \
                asm volatile("s_nop 1\n\tv_writelane_b32 %0, %1, " #r : "+v"(w0lo) : "s"((unsigned)m0)); asm volatile("v_writelane_b32 %0, %1, " #r : "+v"(w0hi) : "s"((unsigned)(m0 >> 32))); } \
            if constexpr ((r) + 64 < NREG) { const unsigned long long m1 = __ballot(k[(r) + 64 < NREG ? (r) + 64 : 0] >= pth); \
                asm volatile("s_nop 1\n\tv_writelane_b32 %0, %1, " #r : "+v"(w1lo) : "s"((unsigned)m1)); asm volatile("v_writelane_b32 %0, %1, " #r : "+v"(w1hi) : "s"((unsigned)(m1 >> 32))); } \
            __builtin_amdgcn_sched_barrier(0); }
        WL1(0) WL1(1) WL1(2) WL1(3) WL1(4) WL1(5) WL1(6) WL1(7) WL1(8) WL1(9)
        WL1(10) WL1(11) WL1(12) WL1(13) WL1(14) WL1(15) WL1(16) WL1(17) WL1(18) WL1(19)
        WL1(20) WL1(21) WL1(22) WL1(23) WL1(24) WL1(25) WL1(26) WL1(27) WL1(28) WL1(29)
        WL1(30) WL1(31) WL1(32) WL1(33) WL1(34) WL1(35) WL1(36) WL1(37) WL1(38) WL1(39)
        WL1(40) WL1(41) WL1(42) WL1(43) WL1(44) WL1(45) WL1(46) WL1(47) WL1(48) WL1(49)
        WL1(50) WL1(51) WL1(52) WL1(53) WL1(54) WL1(55) WL1(56) WL1(57) WL1(58) WL1(59)
        WL1(60) WL1(61) WL1(62) WL1(63)
#undef WL1
        u32x2* brow = (u32x2*)brow64;
        u32x2 v0; v0.x = w0lo; v0.y = w0hi; u32x2 v1; v1.x = w1lo; v1.y = w1hi;
        brow[lane] = v0; brow[64 + lane] = v1;
    }
    if (need > 0) {
        asm volatile("s_waitcnt vmcnt(0)" ::: "memory");
        int filled = 0;
#pragma unroll 1
        for (int r = 0; r * 64 <= t && filled < need; ++r) {
            const int s = r * 64 + lane; unsigned key = 0u;
            if (s <= t) { const unsigned u = __builtin_bit_cast(unsigned, row[s]); key = (u & 0x80000000u) ? ~u : (u | 0x80000000u); }
            const bool eq = key == ptie;
            const unsigned long long me = __ballot(eq);
            const int pe = filled + (int)__builtin_amdgcn_mbcnt_hi((unsigned)(me >> 32), __builtin_amdgcn_mbcnt_lo((unsigned)me, 0u));
            const unsigned long long take = __ballot(eq && pe < need);
            if (lane == 0 && take != 0ull) atomicOr(brow64 + r, take);
            filled += __popcll(me);
        }
    }
}
__device__ __forceinline__ void dsa_unit(unsigned char* ldsg, const bf16* P, const bf16* IK, unsigned long long* bits, float* scr, int b, int t0) {
    LAS unsigned char* lds = (LAS unsigned char*)ldsg;
    const int tid = launder_tid(), lane = tid & 63, wid = __builtin_amdgcn_readfirstlane(tid >> 6);
    const size_t rowbase = (size_t)b * SEQ;
    {
        const int c16 = lane & 15, g4 = lane >> 4;
        const bf16* qrow = P + (rowbase + t0 + c16) * PW;
        bf16x8 bq[8][2];
#pragma unroll
        for (int hh = 0; hh < 8; ++hh)
#pragma unroll
            for (int ks = 0; ks < 2; ++ks) bq[hh][ks] = *(const bf16x8*)(qrow + COL_IQ + hh * 64 + ks * 32 + 8 * g4);
        float w[8];
        { const u32x4 wv = *(const u32x4*)(qrow + COL_IW); w[0] = bflo(wv.x); w[1] = bfhi(wv.x); w[2] = bflo(wv.y); w[3] = bfhi(wv.y); w[4] = bflo(wv.z); w[5] = bfhi(wv.z); w[6] = bflo(wv.w); w[7] = bfhi(wv.w); }
        const int nkt = t0 / 16 + 1;
        for (int kt = wid; kt < nkt; kt += NWAVES) {
            const bf16* krow = IK + (rowbase + 16 * kt + c16) * 64 + 8 * g4;
            const bf16x8 a0 = *(const bf16x8*)krow, a1 = *(const bf16x8*)(krow + 32);
            f32x4 sc = {0.f, 0.f, 0.f, 0.f};
#pragma unroll
            for (int hh = 0; hh < 8; ++hh) {
                f32x4 z = {0.f, 0.f, 0.f, 0.f};
                z = __builtin_amdgcn_mfma_f32_16x16x32_bf16(a0, bq[hh][0], z, 0, 0, 0);
                z = __builtin_amdgcn_mfma_f32_16x16x32_bf16(a1, bq[hh][1], z, 0, 0, 0);
#pragma unroll
                for (int e = 0; e < 4; ++e) sc[e] += w[hh] * fmaxf(z[e], 0.f);
            }
            *(f32x4*)(scr + (size_t)c16 * SEQ + 16 * kt + 4 * g4) = sc;
        }
    }
    __syncthreads();
    __builtin_amdgcn_fence(__ATOMIC_ACQUIRE, "agent");
    for (int qq = wid; qq < 16; qq += NWAVES) {
        const int t = t0 + qq;
        const float* row = scr + (size_t)qq * SEQ;
        unsigned long long* brow64 = bits + (rowbase + t) * 128;
        const int nch = (t >> 6) + 1;
        if (nch <= 32) select_query<32>(row, t, lane, brow64);
        else if (nch <= 64) select_query<64>(row, t, lane, brow64);
        else if (nch <= 96) select_query<96>(row, t, lane, brow64);
        else select_query<128>(row, t, lane, brow64);
    }
    __syncthreads();
}

__device__ __forceinline__ void dsa_attn_unit(unsigned char* ldsg, const bf16* P, const unsigned long long* bits, bf16* O, int b, int h, int qb) {
    LAS unsigned char* lds = (LAS unsigned char*)ldsg;
    const int tid = launder_tid(), lane = tid & 63, wid = __builtin_amdgcn_readfirstlane(tid >> 6), r32 = lane & 31, hi = lane >> 5;
    const int q0 = qb * 256, qmin = q0 + wid * 32, myq = qmin + r32;
    const size_t rowbase = (size_t)b * SEQ;
    constexpr int RS = 144, TILE = 64 * RS;
    LAS float* wsf = (LAS float*)(lds + 4 * TILE) + wid * 32;
    const LAS float* lut = (const LAS float*)(lds + LDS_LUT) + h * 129;
    bf16x8 qr[4];
    { const bf16* qp = P + (rowbase + myq) * PW + COL_QA + h * 64 + hi * 8;
#pragma unroll
      for (int d0 = 0; d0 < 4; ++d0) qr[d0] = *(const bf16x8*)(qp + d0 * 16); }
    const int NT = 4 * qb + 4;
    f32x16 o[2];
#pragma unroll
    for (int d = 0; d < 2; ++d)
#pragma unroll
        for (int i = 0; i < 16; ++i) o[d][i] = 0.f;
    float mrun = -INFINITY, lrun = 0.f;
    const float SC = 0.125f * LOG2E;
    const int lrow = tid >> 3, lc16 = tid & 7;
    const bf16* kg = P + (rowbase + lrow) * PW + COL_KA + h * 64 + lc16 * 8;
    const bf16* vg = P + (rowbase + lrow) * PW + COL_VA + h * 64 + lc16 * 8;
    u32x4 kr = *(const u32x4*)kg, vr = *(const u32x4*)vg;
    const u32x2* brow = (const u32x2*)(bits + (rowbase + myq) * 128);
    u32x2 wnext = brow[0];
    const int q4 = (lane & 15) >> 2;
    const int vcol = (16 * ((lane >> 4) & 1) + 4 * (lane & 3)) * 2;
    for (int t = 0; t < NT; ++t) {
        const int buf = t & 1;
        LAS unsigned char* Kb = lds + buf * TILE; LAS unsigned char* Vb = lds + (2 + buf) * TILE;
        *(LAS u32x4*)(Kb + lrow * RS + lc16 * 16) = kr; *(LAS u32x4*)(Vb + lrow * RS + lc16 * 16) = vr;
        __syncthreads();
        const u32x2 w = wnext;
        if (t + 1 < NT) { kr = *(const u32x4*)(kg + (size_t)(64 * (t + 1)) * PW); vr = *(const u32x4*)(vg + (size_t)(64 * (t + 1)) * PW); wnext = brow[t + 1]; }
        const int kb0 = 64 * t;
        if (kb0 > qmin + 31) continue;
        if (!__any((w.x | w.y) != 0u)) continue;
        f32x16 p0, p1;
#pragma unroll
        for (int i = 0; i < 16; ++i) { p0[i] = 0.f; p1[i] = 0.f; }
#pragma unroll
        for (int d0 = 0; d0 < 4; ++d0) {
            const bf16x8 a0 = *(const LAS bf16x8*)(Kb + r32 * RS + (d0 * 16 + hi * 8) * 2);
            const bf16x8 a1 = *(const LAS bf16x8*)(Kb + (32 + r32) * RS + (d0 * 16 + hi * 8) * 2);
            p0 = __builtin_amdgcn_mfma_f32_32x32x16_bf16(a0, qr[d0], p0, 0, 0, 0);
            p1 = __builtin_amdgcn_mfma_f32_32x32x16_bf16(a1, qr[d0], p1, 0, 0, 0);
        }
        const unsigned wl = w.x >> (4 * hi), wh = w.y >> (4 * hi);
        if (qmin - (kb0 + 63) >= 128) {
            const float c = lut[128];
#pragma unroll
            for (int i = 0; i < 16; ++i) { const unsigned bm = 1u << ((i & 3) + 8 * (i >> 2));
                p0[i] = (wl & bm) ? p0[i] * SC + c : -INFINITY; p1[i] = (wh & bm) ? p1[i] * SC + c : -INFINITY; }
        } else {
#pragma unroll
            for (int i = 0; i < 16; ++i) { const unsigned bm = 1u << ((i & 3) + 8 * (i >> 2));
                const int n0 = myq - (kb0 + crow(i, hi)), n1 = n0 - 32;
                const float b0 = lut[n0 < 0 ? 0 : (n0 > 128 ? 128 : n0)], b1 = lut[n1 < 0 ? 0 : (n1 > 128 ? 128 : n1)];
                p0[i] = (wl & bm) ? p0[i] * SC + b0 : -INFINITY; p1[i] = (wh & bm) ? p1[i] * SC + b1 : -INFINITY; }
        }
        float rm = fmaxf(p0[0], p1[0]);
#pragma unroll
        for (int i = 1; i < 16; ++i) rm = fmaxf(rm, fmaxf(p0[i], p1[i]));
        rm = fmaxf(rm, __shfl_xor(rm, 32));
        const float mnew = fmaxf(mrun, rm);
        const float msafe = (mnew == -INFINITY) ? 0.f : mnew;
        const float f = (mrun == -INFINITY) ? 1.0f : __builtin_amdgcn_exp2f(mrun - msafe);
        mrun = mnew;
        float ls = 0.f;
#pragma unroll
        for (int i = 0; i < 16; ++i) { p0[i] = __builtin_amdgcn_exp2f(p0[i] - msafe); p1[i] = __builtin_amdgcn_exp2f(p1[i] - msafe); ls += p0[i] + p1[i]; }
        lrun = lrun * f + ls;
        if (__any(f != 1.0f)) {
            if (hi == 0) wsf[r32] = f;
            __builtin_amdgcn_wave_barrier();
#pragma unroll
            for (int i = 0; i < 16; ++i) { const float fi = wsf[crow(i, hi)]; o[0][i] *= fi; o[1][i] *= fi; }
            __builtin_amdgcn_wave_barrier();
        }
        bf16x8 pa[4]; pa[0] = pack8(p0, 0); pa[1] = pack8(p0, 1); pa[2] = pack8(p1, 0); pa[3] = pack8(p1, 1);
#pragma unroll
        for (int d0 = 0; d0 < 2; ++d0)
#pragma unroll
            for (int ks = 0; ks < 4; ++ks) {
                const LAS unsigned char* vp = Vb + (16 * ks + 4 * hi + q4) * RS + d0 * 64 + vcol;
                const s16x4 lo = vtr(vp), hh = vtr(vp + 8 * RS);
                const bf16x8 vf = __builtin_shufflevector(lo, hh, 0, 1, 2, 3, 4, 5, 6, 7);
                o[d0] = __builtin_amdgcn_mfma_f32_32x32x16_bf16(pa[ks], vf, o[d0], 0, 0, 0);
            }
    }
    lrun += __shfl_xor(lrun, 32);
    if (hi == 0) wsf[r32] = 1.0f / lrun;
    __builtin_amdgcn_wave_barrier();
#pragma unroll
    for (int i = 0; i < 16; ++i) { const float fi = wsf[crow(i, hi)];
        bf16* orow = O + (rowbase + qmin + crow(i, hi)) * DM + h * 64 + r32;
        orow[0] = (bf16)f2bf(o[0][i] * fi); orow[32] = (bf16)f2bf(o[1][i] * fi); }
    __syncthreads();
}

__device__ __forceinline__ void att_phase(const Params& p, unsigned char* ldsg, int layer) {
    const int tid = launder_tid();
    const int j = layer >> 1;
    unsigned char* ws = p.ws;
    const bf16* P = (const bf16*)(ws + WS_PB); const bf16* IK = (const bf16*)(ws + WS_IK); bf16* O = (bf16*)(ws + WS_XB);
    float* scr = (float*)(ws + WS_SCR) + (size_t)blockIdx.x * 16 * SEQ;
    LAS float* lut = (LAS float*)((LAS unsigned char*)ldsg + LDS_LUT);
    LAS float* misc = lut + 12 * 129;
    const float* relb = p.in[5];
    for (int i = tid; i < 12 * 129; i += NTHREADS) { const int hd = i / 129, n = i % 129; lut[i] = relb[t5_bucket(n) * 12 + hd] * LOG2E; }
    if (tid < 64) {
        const float* lam = p.in[9] + (size_t)j * 4 * 64;
        const float a = wave_sum(lam[tid] * lam[64 + tid]), bb = wave_sum(lam[128 + tid] * lam[192 + tid]);
        if (tid == 0) misc[0] = a, misc[1] = bb;
    }
    __syncthreads();
    const float lam_init = 0.8f - 0.6f * expf(-0.3f * (float)layer);
    const float lam_full = expf(misc[0]) - expf(misc[1]) + lam_init;
    const float* subg = p.in[10] + (size_t)j * 128;
    for (int rep = 0; rep < DUP_DIFF; ++rep)
    for (int c = blockIdx.x; c < 256; c += gridDim.x) {
        const int b = c >> 7, h = (c >> 5) & 3, i = c & 31;
        if (EN_DIFF) diff_unit(ldsg, P, O, b, h, 63 - i, lam_full, 1.0f - lam_init, subg);
        if (EN_DIFF) diff_unit(ldsg, P, O, b, h, i, lam_full, 1.0f - lam_init, subg);
    }
    unsigned long long* bits = (unsigned long long*)(ws + WS_BITS);
    for (int rep = 0; rep < DUP_DSA; ++rep)
    for (int c = blockIdx.x; c < 256; c += gridDim.x) {
#pragma unroll 1
        for (int kq = 0; kq < 4; ++kq) {
            const int id = (kq == 0) ? 1023 - c : (kq == 1) ? 512 + c : (kq == 2) ? 511 - c : c;
            if (EN_DSA) dsa_unit(ldsg, P, IK, bits, scr, id & 1, (id >> 1) * 16);
        }
    }
}
__device__ __forceinline__ void attb_phase(const Params& p, unsigned char* ldsg) {
    const int tid = launder_tid();
    unsigned char* ws = p.ws;
    const bf16* P = (const bf16*)(ws + WS_PB); bf16* O = (bf16*)(ws + WS_XB);
    const unsigned long long* bits = (const unsigned long long*)(ws + WS_BITS);
    LAS float* lut = (LAS float*)((LAS unsigned char*)ldsg + LDS_LUT);
    const float* relb = p.in[5];
    for (int i = tid; i < 8 * 129; i += NTHREADS) { const int hd = i / 129, n = i % 129; lut[i] = relb[t5_bucket(n) * 12 + hd] * LOG2E; }
    __syncthreads();
    for (int rep = 0; rep < DUP_ATTB; ++rep)
    for (int c = blockIdx.x; c < 256; c += gridDim.x) {
        const int b = c >> 7, h = (c >> 4) & 7, i = c & 15;
        dsa_attn_unit(ldsg, P, bits, O, b, h, 31 - i);
        dsa_attn_unit(ldsg, P, bits, O, b, h, i);
    }
}

#define XB_TMO      128
#define XB_XCNT(j)  (256  + 64 * (j))
#define XB_XSUB(j)  (1280 + 64 * (j))
#define XB_XGEN(j)  (2304 + 64 * (j))
#define XB_TOP      3328
#define XB_TOPGEN   3392
#define XCD_BAR_WORDS 3456
#define XB_SPIN_CAP (1u << 18)

__device__ __forceinline__ unsigned xb_ld(unsigned* p)              { return __hip_atomic_load(p, __ATOMIC_RELAXED, __HIP_MEMORY_SCOPE_AGENT); }
__device__ __forceinline__ unsigned xb_add(unsigned* p, unsigned v) { return __hip_atomic_fetch_add(p, v, __ATOMIC_RELAXED, __HIP_MEMORY_SCOPE_AGENT); }
__device__ __forceinline__ unsigned xb_xcc_id() { return (unsigned)__builtin_amdgcn_s_getreg((3 << 11) | 20) & 0xFu; }
#define XB_SPIN(cond, bar) do { unsigned _sp = 0; while (cond) { __builtin_amdgcn_s_sleep(1); \
    if ((++_sp & 255u) == 0u) { if (xb_ld(&(bar)[XB_TMO])) break; if (_sp > XB_SPIN_CAP) { atomicAdd(&(bar)[XB_TMO], 1u); break; } } } } while (0)

struct XcdBarrier {
    unsigned* bar; unsigned x;
    volatile LAS unsigned* st;
};

__device__ __forceinline__ XcdBarrier xcd_barrier_post(unsigned* bar, volatile LAS unsigned* st) {
    XcdBarrier b; b.bar = bar; b.x = xb_xcc_id(); b.st = st;
    if (threadIdx.x == 0) (void)xb_add(&bar[XB_XCNT(b.x)], 1u);
    return b;
}
__device__ __forceinline__ void xcd_barrier_complete(unsigned* bar, unsigned x, unsigned& nloc, unsigned& nx) {
    const unsigned G = gridDim.x * gridDim.y * gridDim.z;
    unsigned sum, cnt, mine, sp = 0u;
    for (;;) {
        sum = 0u; cnt = 0u; mine = 0u;
#pragma unroll
        for (unsigned j = 0; j < 16; ++j) { const unsigned c = xb_ld(&bar[XB_XCNT(j)]); sum += c; cnt += (c > 0u) ? 1u : 0u; mine = (j == x) ? c : mine; }
        if (sum == G) break;
        __builtin_amdgcn_s_sleep(1);
        if ((++sp & 255u) == 0u) { if (xb_ld(&bar[XB_TMO])) break; if (sp > XB_SPIN_CAP) { atomicAdd(&bar[XB_TMO], 1u); break; } }
    }
    nloc = mine > 0u ? mine : 1u; nx = cnt > 0u ? cnt : 1u;
}

__device__ __forceinline__ void xcd_barrier(const XcdBarrier& b) {
    asm volatile("s_waitcnt vmcnt(0)" ::: "memory");
    __syncthreads();
    if (threadIdx.x == 0) {
        unsigned* bar = b.bar;
        __builtin_amdgcn_s_waitcnt(0);
        unsigned nloc = b.st[0], nx = b.st[1];
        if (nloc == 0u) { xcd_barrier_complete(bar, b.x, nloc, nx); b.st[0] = nloc; b.st[1] = nx; }
        const unsigned old = xb_add(&bar[XB_XSUB(b.x)], 1u);
        const unsigned gen = old / nloc;
        if (old + 1u == (gen + 1u) * nloc) {
            __builtin_amdgcn_fence(__ATOMIC_RELEASE, "agent");
            asm volatile("s_waitcnt vmcnt(0)" ::: "memory");
            const unsigned og = xb_add(&bar[XB_TOP], 1u);
            const unsigned tg = og / nx;
            if (og + 1u == (tg + 1u) * nx) xb_add(&bar[XB_TOPGEN], 1u);
            else XB_SPIN(xb_ld(&bar[XB_TOPGEN]) == tg, bar);
            __builtin_amdgcn_fence(__ATOMIC_ACQUIRE, "agent");
            xb_add(&bar[XB_XGEN(b.x)], 1u);
            asm volatile("s_waitcnt vmcnt(0)" ::: "memory");
        } else {
            XB_SPIN(xb_ld(&bar[XB_XGEN(b.x)]) == gen, bar);
            __builtin_amdgcn_fence(__ATOMIC_ACQUIRE, "agent");
            asm volatile("s_waitcnt vmcnt(0)" ::: "memory");
        }
    }
    __syncthreads();
}

__global__ void __launch_bounds__(NTHREADS, 2) fwd_kernel(Params p) {
    extern __shared__ __attribute__((aligned(16))) unsigned char lds[];
    cg::grid_group grid = cg::this_grid();
    volatile LAS unsigned* bst = (volatile LAS unsigned*)((LAS unsigned char*)lds + LDS_LUT + 7168);
    if (threadIdx.x == 0) { bst[0] = 0u; bst[1] = 0u; }
    __syncthreads();
    XcdBarrier xbar = xcd_barrier_post((unsigned*)(p.ws + WS_CTL), bst);
    unsigned char* ws = p.ws;
    bf16* XB = (bf16*)(ws + WS_XB); bf16* PB = (bf16*)(ws + WS_PB); float* Y = (float*)(ws + WS_Y);
    for (int ph = p.ph_lo; ph < p.ph_hi; ++ph) {
        if (ph > p.ph_lo) { if (ph == 1) grid.sync(); else xcd_barrier(xbar); for (int e_ = 0; e_ < DUP_SYNC; ++e_) xcd_barrier(xbar); }
        if (ph == 0) { for (int e_ = 0; e_ < DUP_PRO; ++e_) prologue_phase(p, lds); continue; }
        int l, s;
        if (ph < 13) { l = 0; s = ph - 1; } else if (ph < 23) { l = 1; s = ph - 13; } else if (ph < 35) { l = 2; s = ph - 23; } else { l = 3; s = ph - 35; }
        if (l & 1) s = (s < 4) ? s : (s == 4) ? 5 : s + 2;
        const int j = l >> 1;
        const float* base = (ph <= 2) ? p.in[0] : p.out;
        for (int rep_ = 0; rep_ < (((DUP_PH >> s) & 1) ? 2 : 1); ++rep_)
        if (s == 0 || s == 9) {
            const int f = (s == 9);
            pg8::Gemm g{XB, (const bf16*)(ws + WS_WFI + (size_t)(l * 2 + f) * SZ_WFI), MTOK, 5632, 1024}; pg8::StaticOrder S; S.init(MTOK, 5632, gridDim.x, blockIdx.x);
            pg8::EpiAct E{PB, DFF, 0};
            if (EN_GEMM1) pg8::gemm_phase<pg8::EpiAct, pg8::StaticOrder, true, true>((PG8_LAS unsigned char*)lds, g, S, E);
        } else if (s == 3 && (l & 1)) {
            pg8::Gemm g{XB, (const bf16*)(ws + WS_WCI + (size_t)j * SZ_WCI), MTOK, 2048, 1024}; pg8::StaticOrder S; S.init(MTOK, 2048, gridDim.x, blockIdx.x);
            pg8::EpiAct E{PB, DM, 1};
            if (EN_GEMM1) pg8::gemm_phase<pg8::EpiAct, pg8::StaticOrder, true, true>((PG8_LAS unsigned char*)lds, g, S, E);
        } else if (s == 1 || s == 10) {
            const int f = (s == 10);
            pg8::Gemm g{PB, (const bf16*)(ws + WS_WFO + (size_t)(l * 2 + f) * SZ_WFO), MTOK, DM, DFF}; pg8::StaticOrder S; S.init(MTOK, DM, gridDim.x, blockIdx.x);
            pg8::EpiRes E{base, Y, DM, ALPHA, 0.5f};
            if (EN_GEMM2) pg8::gemm_phase<pg8::EpiRes, pg8::StaticOrder, true, true>((PG8_LAS unsigned char*)lds, g, S, E);
        } else if (s == 7) {
            const bf16* Wt = (l & 1) ? (const bf16*)(ws + WS_WCO + (size_t)j * SZ_WCO) : (const bf16*)(ws + WS_WMO + (size_t)j * SZ_WMO);
            pg8::Gemm g{XB, Wt, MTOK, DM, DM}; pg8::StaticOrder S; S.init(MTOK, DM, gridDim.x, blockIdx.x);
            pg8::EpiRes E{base, Y, DM, ALPHA, 1.0f};
            if (EN_GEMM2) pg8::gemm_phase<pg8::EpiRes, pg8::StaticOrder, true, true>((PG8_LAS unsigned char*)lds, g, S, E);
        } else if (s == 3) {
            pg8::Gemm g{XB, (const bf16*)(ws + WS_WMI + (size_t)j * SZ_WMI), MTOK, PW, 1024}; pg8::StaticOrder S; S.init(MTOK, PW, gridDim.x, blockIdx.x);
            pg8::EpiBf16 E{PB, PW};
            if (EN_GEMM3) pg8::gemm_phase<pg8::EpiBf16, pg8::StaticOrder, true, true>((PG8_LAS unsigned char*)lds, g, S, E);
        } else if (s == 2 || s == 8 || s == 11) {
            const int which = (s == 2) ? 0 : (s == 8) ? 1 : 2;
            if (EN_LN) ln_phase(Y, p.in[3] + (size_t)(l * 3 + which) * DM, p.in[4] + (size_t)(l * 3 + which) * DM, p.out, XB);
        } else if (s == 4) {
            if (EN_IKLN) ikln_phase(PB, p.in[7] + (size_t)j * 64, p.in[8] + (size_t)j * 64, (bf16*)(ws + WS_IK));
        } else if (s == 5 && !(l & 1)) {
            att_phase(p, lds, l);
        } else if (s == 6) {
            attb_phase(p, lds);
        } else if (s == 5) {
            for (int e_ = 0; e_ < DUP_CONV; ++e_) conv_phase(PB, p.in[13] + (size_t)j * 31 * DM, p.in[14] + (size_t)j * DM, p.in[15] + (size_t)j * DM, p.in[16] + (size_t)j * DM, XB);
        }
    }
}
constexpr int NPHASES = 45;

#ifndef ONE_LAUNCH
#define ONE_LAUNCH 1
#endif
extern "C" void kernel_launch(void* const* d_in, const int* in_sizes, int n_in, void* d_out, int out_size, void* d_ws, size_t ws_size, hipStream_t stream) {
    static int grid = 0;
    if (grid == 0) {
        if (n_in != 18 || in_sizes[0] != MTOK * DM || out_size != MTOK * DM || ws_size < WS_END) { fprintf(stderr, "kernel_launch: unexpected shapes (n_in %d, in0 %d, out %d, ws %zu)\n", n_in, n_in > 0 ? in_sizes[0] : -1, out_size, ws_size); grid = -1; return; }
        int dev = 0, cus = 0, per_cu = 0;
        if (hipGetDevice(&dev) != hipSuccess || hipDeviceGetAttribute(&cus, hipDeviceAttributeMultiprocessorCount, dev) != hipSuccess) { grid = -1; return; }
        if (hipFuncSetAttribute((const void*)fwd_kernel, hipFuncAttributeMaxDynamicSharedMemorySize, LDS_BYTES) != hipSuccess) { fprintf(stderr, "kernel_launch: hipFuncSetAttribute failed\n"); grid = -1; return; }
        if (hipOccupancyMaxActiveBlocksPerMultiprocessor(&per_cu, (const void*)fwd_kernel, NTHREADS, LDS_BYTES) != hipSuccess || per_cu < 1) { fprintf(stderr, "kernel_launch: occupancy query gave %d\n", per_cu); per_cu = 1; }
        (void)hipGetLastError();
        grid = cus;
    }
    if (grid < 0) return;
    Params p{};
    for (int i = 0; i < 18; ++i) p.in[i] = (const float*)d_in[i];
    p.out = (float*)d_out; p.ws = (unsigned char*)d_ws;
    if (hipMemsetAsync((char*)d_ws + WS_CTL, 0, CTL_BYTES, stream) != hipSuccess) { fprintf(stderr, "kernel_launch: memset failed\n"); return; }
#if ONE_LAUNCH
    p.ph_lo = 0; p.ph_hi = NPHASES;
    void* args[] = {&p};
    hipError_t e = hipLaunchCooperativeKernel((const void*)fwd_kernel, dim3(grid), dim3(NTHREADS), args, LDS_BYTES, stream);
    if (e != hipSuccess) fprintf(stderr, "cooperative launch failed: %s (grid %d)\n", hipGetErrorString(e), grid);
#else
    for (int ph = 0; ph < NPHASES; ++ph) { p.ph_lo = ph; p.ph_hi = ph + 1; hipLaunchKernelGGL(fwd_kernel, dim3(grid), dim3(NTHREADS), LDS_BYTES, stream, p); }
#endif
}
```

```cpp
#include <hip/hip_runtime.h>
#include <hip/hip_cooperative_groups.h>
#include <cstdio>
#include <cstdint>
#include <cmath>
namespace cg = cooperative_groups;
namespace pg8 {
#define PG8_LAS __attribute__((address_space(3)))
typedef unsigned short bf16_t;
typedef short bf16x8 __attribute__((ext_vector_type(8)));
typedef float f32x4 __attribute__((ext_vector_type(4)));
typedef unsigned u32x4 __attribute__((ext_vector_type(4)));
constexpr int BM = 256, BK = 64, HALF = 128, HTB = HALF * BK * 2  , STAGE_BYTES = 8 * HTB, NXCD = 8, WGM = 8;

__host__ __device__ __forceinline__ int lds_byte(int r, int c) { const int st = (r >> 4) * 2 + (c >> 5), rr = r & 15, cc = c & 31, ob = rr * 64 + cc * 2; return st * 1024 + (ob ^ (((ob >> 9) & 1) << 5)); }
__host__ __device__ __forceinline__ void stage_rc(int b, int& R, int& C) { const int st = b / 1024, sb = b % 1024, swz = sb ^ (((sb >> 9) & 1) << 5); R = (st >> 1) * 16 + swz / 64; C = (st & 1) * 32 + (swz % 64) / 2; }
__host__ __device__ __forceinline__ int perm32(int rho) { const int n = rho >> 4, i = rho & 15; return 8 * (i >> 2) + 4 * n + (i & 3); }

struct Unit { int pm, pn; };
struct Gemm { const bf16_t* A; const bf16_t* Bt; int M, N, K; };

struct StaticOrder {
    int nM, nN, nwg, G, c;
    __host__ __device__ void init(int M, int N, int G_, int c_) { nM = M / BM; nN = N / BM; nwg = nM * nN; G = G_; c = c_; }
    __host__ __device__ bool next(int i, Unit& u) const {
        const long L = (long)i * G + c; if (L >= nwg) return false;
        int wgid = (int)L; { const int q = nwg / NXCD, r = nwg % NXCD, xcd = wgid % NXCD, off = wgid / NXCD; wgid = (xcd < r ? xcd * (q + 1) : r * (q + 1) + (xcd - r) * q) + off; }
        const int nig = WGM * nN, gid = wgid / nig, fm = gid * WGM, gsz = (nM - fm) < WGM ? (nM - fm) : WGM;
        u.pm = fm + ((wgid % nig) % gsz); u.pn = (wgid % nig) / gsz; return true;
    }
    __device__ __forceinline__ void a_ready(const Unit&) const {}
    __device__ __forceinline__ void done(const Unit&) const {}
};

__device__ __forceinline__ unsigned cvt_pk_bf16(float lo, float hi) { unsigned r; asm volatile("v_cvt_pk_bf16_f32 %0, %1, %2" : "=v"(r) : "v"(lo), "v"(hi)); return r; }
typedef float f32x2 __attribute__((ext_vector_type(2)));
typedef unsigned u32x4 __attribute__((ext_vector_type(4)));
__device__ __forceinline__ float sigmoidf_fast(float x) { return __builtin_amdgcn_rcpf(1.0f + __builtin_amdgcn_exp2f(-1.4426950408889634f * x)); }
struct EpiBf16 {
    static constexpr bool PERM = true, AFTER_DRAIN = false;
    bf16_t* O; int ldc;
    __device__ __forceinline__ void operator()(const f32x4 (&acc)[2][2][4][2], const Unit& u, int wr, int wc, int fr, int fq) const {
        const int row0 = u.pm * BM + wr * 64 + fr; const int col0 = u.pn * BM + wc * 32 + 8 * fq;
#pragma unroll
        for (int ai = 0; ai < 2; ++ai)
#pragma unroll
            for (int m = 0; m < 4; ++m) { bf16_t* rowp = O + (size_t)(row0 + ai * HALF + m * 16) * ldc + col0;
#pragma unroll
                for (int bj = 0; bj < 2; ++bj) { const f32x4 v0 = acc[ai][bj][m][0], v1 = acc[ai][bj][m][1];
                    u32x4 w; w.x = cvt_pk_bf16(v0[0], v0[1]); w.y = cvt_pk_bf16(v0[2], v0[3]); w.z = cvt_pk_bf16(v1[0], v1[1]); w.w = cvt_pk_bf16(v1[2], v1[3]);
                    *(u32x4*)(rowp + bj * HALF) = w; } }
    }
};
struct EpiAct {
    static constexpr bool PERM = true, AFTER_DRAIN = false;
    bf16_t* O; int ldc; int mode;
    __device__ __forceinline__ void operator()(const f32x4 (&acc)[2][2][4][2], const Unit& u, int wr, int wc, int fr, int fq) const {
        const int row0 = u.pm * BM + wr * 64 + fr; const int col0 = u.pn * HALF + wc * 32 + 8 * fq;
#pragma unroll
        for (int ai = 0; ai < 2; ++ai)
#pragma unroll
            for (int m = 0; m < 4; ++m) { bf16_t* rowp = O + (size_t)(row0 + ai * HALF + m * 16) * ldc + col0;
                float r[8];
#pragma unroll
                for (int n = 0; n < 2; ++n)
#pragma unroll
                    for (int e = 0; e < 4; ++e) { const float a = acc[ai][0][m][n][e], b = acc[ai][1][m][n][e];
                        const float s = sigmoidf_fast(mode ? b : a); r[4 * n + e] = mode ? a * s : a * s * b; }
                u32x4 w; w.x = cvt_pk_bf16(r[0], r[1]); w.y = cvt_pk_bf16(r[2], r[3]); w.z = cvt_pk_bf16(r[4], r[5]); w.w = cvt_pk_bf16(r[6], r[7]);
                *(u32x4*)rowp = w; }
    }
};
struct EpiRes {
    static constexpr bool PERM = false, AFTER_DRAIN = false;
    const float* base; float* out; int ldc; float alpha, scale;
    __device__ __forceinline__ void operator()(const f32x4 (&acc)[2][2][4][2], const Unit& u, int wr, int wc, int fr, int fq) const {
        const int col0 = u.pn * BM + wc * 32 + 4 * fq;
#pragma unroll
        for (int ai = 0; ai < 2; ++ai)
#pragma unroll
            for (int m = 0; m < 4; ++m) { const int r = u.pm * BM + ai * HALF + wr * 64 + m * 16 + fr; const size_t off = (size_t)r * ldc + col0;
#pragma unroll
                for (int bj = 0; bj < 2; ++bj)
#pragma unroll
                    for (int n = 0; n < 2; ++n) { const f32x4 bs = *(const f32x4*)(base + off + bj * HALF + n * 16);
                        *(f32x4*)(out + off + bj * HALF + n * 16) = bs * alpha + acc[ai][bj][m][n] * scale; } }
    }
};
template <class Epi, class Sched, bool ALIGN_EPI = false, bool SP2 = false>
__device__ __forceinline__ void gemm_phase(PG8_LAS unsigned char* lds, const Gemm g, const Sched& S, const Epi& E) {
    int tid_ = threadIdx.x; asm volatile("" : "+v"(tid_));
    const int tid = tid_, wid = __builtin_amdgcn_readfirstlane(tid >> 6), lane = tid & 63, wr = wid >> 2, wc = wid & 3, fr = lane & 15, fq = lane >> 4;
    const int K = g.K, nt = K / BK;
    unsigned voffA[2], voffB[2];
#pragma unroll
    for (int i = 0; i < 2; ++i) { int R, C; stage_rc(tid * 16 + i * 8192, R, C); const int Rb = Epi::PERM ? ((R & ~31) + perm32(R & 31)) : R;
        voffA[i] = (unsigned)(R * K + C) * 2u; voffB[i] = (unsigned)(Rb * K + C) * 2u; }
    const size_t kstep = (size_t)(BK * 2);
    const size_t hstep = (size_t)HALF * K * 2;
    const size_t tstep = 2 * hstep;
    const unsigned ldsw = (unsigned)wid * 1024u;
    const int aoff = lds_byte(wr * 64 + fr, fq * 8), boff = lds_byte(wc * 32 + fr, fq * 8);
#define PG8_SA(b, h) (((b) * 2 + (h)) * HTB)
#define PG8_SB(b, h) ((4 + (b) * 2 + (h)) * HTB)
#define PG8_STAGE(bufoff, gbase, voff) do { _Pragma("unroll") for (int _i = 0; _i < 2; ++_i) \
        __builtin_amdgcn_global_load_lds((const unsigned*)((const char*)(gbase) + (voff)[_i]), (PG8_LAS unsigned*)(lds + (bufoff) + ldsw + _i * 8192), 16, 0, 0); } while (0)
#define PG8_LDA(dst, b, h) do { _Pragma("unroll") for (int m = 0; m < 4; ++m) _Pragma("unroll") for (int k = 0; k < 2; ++k) dst[m][k] = *(const PG8_LAS bf16x8*)(lds + PG8_SA(b, h) + aoff + m * 2048 + k * 1024); } while (0)
#define PG8_LDB(dst, b, h) do { _Pragma("unroll") for (int n = 0; n < 2; ++n) _Pragma("unroll") for (int k = 0; k < 2; ++k) dst[n][k] = *(const PG8_LAS bf16x8*)(lds + PG8_SB(b, h) + boff + n * 2048 + k * 1024); } while (0)
#define PG8_MMA(ai, bj, At, Bt) do { __builtin_amdgcn_s_setprio(1); _Pragma("unroll") for (int m = 0; m < 4; ++m) _Pragma("unroll") for (int n = 0; n < 2; ++n) _Pragma("unroll") for (int k = 0; k < 2; ++k) \
        acc[ai][bj][m][n] = __builtin_amdgcn_mfma_f32_16x16x32_bf16(Bt[n][k], At[m][k], acc[ai][bj][m][n], 0, 0, 0); __builtin_amdgcn_s_setprio(0); } while (0)
#define PG8_WAIT_V(n) asm volatile("s_waitcnt vmcnt(" #n ")" ::: "memory")
#define PG8_WAIT_L(n) asm volatile("s_waitcnt lgkmcnt(" #n ")" ::: "memory")
#define PG8_BAR __builtin_amdgcn_s_barrier()
#define PG8_SCHED __builtin_amdgcn_sched_barrier(0)
    Unit cur, nxt; int ui = 0;
    if (!S.next(0, cur)) return;
    f32x4 acc[2][2][4][2];
#pragma unroll
    for (int a = 0; a < 2; ++a)
#pragma unroll
        for (int b = 0; b < 2; ++b)
#pragma unroll
            for (int m = 0; m < 4; ++m)
#pragma unroll
                for (int n = 0; n < 2; ++n) acc[a][b][m][n] = (f32x4){0.f, 0.f, 0.f, 0.f};
    bf16x8 At[4][2], B0[2][2], B1[2][2];
    const char* cA = (const char*)g.A + (size_t)cur.pm * tstep; const char* cB = (const char*)g.Bt + (size_t)cur.pn * tstep;
    S.a_ready(cur);
    if constexpr (SP2) {
        PG8_STAGE(PG8_SB(0, 0), cB, voffB); PG8_STAGE(PG8_SB(0, 1), cB + hstep, voffB); PG8_STAGE(PG8_SA(0, 0), cA, voffA); PG8_STAGE(PG8_SA(0, 1), cA + hstep, voffA);
        if (wr == 1) PG8_BAR;
        PG8_WAIT_V(2); PG8_BAR;
        PG8_STAGE(PG8_SB(1, 0), cB + kstep, voffB); PG8_STAGE(PG8_SA(1, 0), cA + kstep, voffA); PG8_STAGE(PG8_SB(1, 1), cB + hstep + kstep, voffB);
        PG8_WAIT_V(6); PG8_BAR;
    } else {
        PG8_STAGE(PG8_SB(0, 0), cB, voffB); PG8_STAGE(PG8_SA(0, 0), cA, voffA); PG8_STAGE(PG8_SB(0, 1), cB + hstep, voffB); PG8_STAGE(PG8_SA(0, 1), cA + hstep, voffA);
        if (wr == 1) PG8_BAR;
        PG8_WAIT_V(4); PG8_BAR;
        PG8_STAGE(PG8_SB(1, 0), cB + kstep, voffB); PG8_STAGE(PG8_SA(1, 0), cA + kstep, voffA); PG8_STAGE(PG8_SB(1, 1), cB + hstep + kstep, voffB);
        PG8_WAIT_V(6); PG8_BAR;
    }
    for (;;) {
        const bool has_next = S.next(ui + 1, nxt);
        const char* nA = has_next ? (const char*)g.A + (size_t)nxt.pm * tstep : cA; const char* nB = has_next ? (const char*)g.Bt + (size_t)nxt.pn * tstep : cB;
        for (int t = 0; t < nt; t += 2) {
            const bool last = (t == nt - 2);
            const char* a1 = cA + (size_t)(t + 1) * kstep;
            const char* a2 = last ? nA : cA + (size_t)(t + 2) * kstep; const char* b2 = last ? nB : cB + (size_t)(t + 2) * kstep;
            const char* a3 = a2 + kstep; const char* b3 = b2 + kstep;
            if (last && has_next) S.a_ready(nxt);
            if constexpr (SP2) {
            PG8_LDB(B0, 0, 0); PG8_LDB(B1, 0, 1); PG8_SCHED; PG8_LDA(At, 0, 0); PG8_STAGE(PG8_SA(1, 1), a1 + hstep, voffA);
            PG8_WAIT_V(8); PG8_WAIT_L(0); PG8_BAR; PG8_MMA(0, 0, At, B0); PG8_MMA(0, 1, At, B1); PG8_BAR; PG8_SCHED;
            PG8_LDA(At, 0, 1); PG8_STAGE(PG8_SB(0, 0), b2, voffB); PG8_STAGE(PG8_SB(0, 1), b2 + hstep, voffB); PG8_STAGE(PG8_SA(0, 0), a2, voffA);
            PG8_WAIT_V(8); PG8_WAIT_L(0); PG8_BAR; PG8_MMA(1, 0, At, B0); PG8_MMA(1, 1, At, B1); PG8_BAR; PG8_SCHED;
            PG8_LDB(B0, 1, 0); PG8_LDB(B1, 1, 1); PG8_SCHED; PG8_LDA(At, 1, 0); PG8_STAGE(PG8_SA(0, 1), a2 + hstep, voffA);
            PG8_WAIT_V(8); PG8_WAIT_L(0); PG8_BAR; PG8_MMA(0, 0, At, B0); PG8_MMA(0, 1, At, B1); PG8_BAR; PG8_SCHED;
            PG8_LDA(At, 1, 1); PG8_STAGE(PG8_SB(1, 0), b3, voffB); PG8_STAGE(PG8_SB(1, 1), b3 + hstep, voffB); PG8_STAGE(PG8_SA(1, 0), a3, voffA);
            PG8_WAIT_V(8); PG8_WAIT_L(0); PG8_BAR; PG8_MMA(1, 0, At, B0); PG8_MMA(1, 1, At, B1); PG8_BAR; PG8_SCHED;
            } else {
            PG8_LDB(B0, 0, 0); PG8_SCHED; PG8_LDA(At, 0, 0); PG8_STAGE(PG8_SA(1, 1), a1 + hstep, voffA);
            PG8_WAIT_L(8); PG8_BAR; PG8_WAIT_L(0); PG8_MMA(0, 0, At, B0); PG8_BAR; PG8_SCHED;
            PG8_LDB(B1, 0, 1); PG8_STAGE(PG8_SB(0, 0), b2, voffB);
            PG8_BAR; PG8_WAIT_L(0); PG8_MMA(0, 1, At, B1); PG8_BAR;
            PG8_LDA(At, 0, 1); PG8_STAGE(PG8_SA(0, 0), a2, voffA);
            PG8_BAR; PG8_WAIT_L(0); PG8_MMA(1, 0, At, B0); PG8_BAR; PG8_SCHED;
            PG8_STAGE(PG8_SB(0, 1), b2 + hstep, voffB);
            PG8_WAIT_V(6); PG8_BAR; PG8_MMA(1, 1, At, B1); PG8_BAR;
            PG8_LDB(B0, 1, 0); PG8_SCHED; PG8_LDA(At, 1, 0); PG8_STAGE(PG8_SA(0, 1), a2 + hstep, voffA);
            PG8_WAIT_L(8); PG8_BAR; PG8_WAIT_L(0); PG8_MMA(0, 0, At, B0); PG8_BAR; PG8_SCHED;
            PG8_LDB(B1, 1, 1); PG8_STAGE(PG8_SB(1, 0), b3, voffB);
            PG8_BAR; PG8_WAIT_L(0); PG8_MMA(0, 1, At, B1); PG8_BAR;
            PG8_LDA(At, 1, 1); PG8_STAGE(PG8_SA(1, 0), a3, voffA);
            PG8_BAR; PG8_WAIT_L(0); PG8_MMA(1, 0, At, B0); PG8_BAR; PG8_SCHED;
            PG8_STAGE(PG8_SB(1, 1), b3 + hstep, voffB);
            PG8_WAIT_V(6); PG8_BAR; PG8_MMA(1, 1, At, B1); PG8_BAR;
            }
        }
        if constexpr (ALIGN_EPI) { if (wr == 0) PG8_BAR; }
        if constexpr (!Epi::AFTER_DRAIN) { E(acc, cur, wr, wc, fr, fq); S.done(cur); }
        if (!has_next) break;
#pragma unroll
        for (int a = 0; a < 2; ++a)
#pragma unroll
            for (int b = 0; b < 2; ++b)
#pragma unroll
                for (int m = 0; m < 4; ++m)
#pragma unroll
                    for (int n = 0; n < 2; ++n) acc[a][b][m][n] = (f32x4){0.f, 0.f, 0.f, 0.f};
        cur = nxt; cA = nA; cB = nB; ++ui;
        if constexpr (ALIGN_EPI) { if (wr == 1) PG8_BAR; }
    }
    PG8_WAIT_V(0);
    if constexpr (!ALIGN_EPI) { if (wr == 0) PG8_BAR; }
    PG8_BAR;
    if constexpr (Epi::AFTER_DRAIN) { E.fused(acc, cur, wr, wc, fr, fq, lds, wid, lane); S.done(cur); }
#undef PG8_SA
#undef PG8_SB
#undef PG8_STAGE
#undef PG8_LDA
#undef PG8_LDB
#undef PG8_MMA
#undef PG8_WAIT_V
#undef PG8_WAIT_L
#undef PG8_BAR
#undef PG8_SCHED
}
}
#ifndef DUP_DIFF
#define DUP_DIFF 1
#endif
#ifndef DUP_DSA
#define DUP_DSA 1
#endif
#ifndef DUP_ATTB
#define DUP_ATTB 1
#endif
#ifndef DUP_PH
#define DUP_PH 0
#endif
#ifndef DUP_SYNC
#define DUP_SYNC 0
#endif
#ifndef DUP_PRO
#define DUP_PRO 1
#endif
#ifndef DUP_CONV
#define DUP_CONV 1
#endif
#ifndef SEL_A
#define SEL_A 64
#endif
#ifndef EN_MASK
#define EN_MASK 0xffff
#endif
#define EN_PRO ((EN_MASK) & 1)
#define EN_GEMM1 ((EN_MASK) & 2)
#define EN_GEMM2 ((EN_MASK) & 4)
#define EN_GEMM3 ((EN_MASK) & 8)
#define EN_LN ((EN_MASK) & 16)
#define EN_IKLN ((EN_MASK) & 32)
#define EN_CONV ((EN_MASK) & 64)
#define EN_DIFF ((EN_MASK) & 128)
#define EN_DSA ((EN_MASK) & 256)
constexpr int SEQ = 8192, NB = 2, MTOK = NB * SEQ, DM = 1024, DFF = 2816, DEPTH = 4;
constexpr int PW = 3840;
constexpr int COL_QA = 0, COL_KA = 512, COL_VA = 1024, COL_IQ = 1536, COL_QB = 2048, COL_KB = 2560, COL_VB = 3072, COL_IK = 3584, COL_IW = 3648;
constexpr int PMIX = 3656;
constexpr float LN_EPS = 1e-5f;
constexpr float ALPHA = 1.6817928305074290f;
constexpr float LOG2E = 1.4426950408889634f;
constexpr int NTHREADS = 512, NWAVES = 8;
constexpr size_t MiB = 1u << 20;
constexpr size_t WS_WFI = 0, SZ_WFI = 11 * MiB;
constexpr size_t WS_WFO = 88 * MiB, SZ_WFO = 5632 * 1024;
constexpr size_t WS_WMI = 132 * MiB, SZ_WMI = (size_t)PW * 1024 * 2;
constexpr size_t WS_WMO = 147 * MiB, SZ_WMO = 2 * MiB;
constexpr size_t WS_WCI = 151 * MiB, SZ_WCI = 4 * MiB;
constexpr size_t WS_WCO = 159 * MiB, SZ_WCO = 2 * MiB;
constexpr size_t WS_XB = 164 * MiB;
constexpr size_t WS_PB = 196 * MiB;
constexpr size_t WS_Y = 316 * MiB;
constexpr size_t WS_SCR = 380 * MiB;
constexpr size_t WS_IK = 508 * MiB;
constexpr size_t WS_BITS = 510 * MiB;
constexpr size_t WS_CTL = 526 * MiB, CTL_BYTES = 65536;
constexpr size_t WS_END = 527 * MiB;
constexpr int LDS_BYTES = 131072 + 8192;
constexpr int LDS_LUT = 131072;

typedef unsigned short bf16;
typedef short bf16x8 __attribute__((ext_vector_type(8)));
typedef short s16x4 __attribute__((ext_vector_type(4)));
typedef float f32x4 __attribute__((ext_vector_type(4)));
typedef float f32x16 __attribute__((ext_vector_type(16)));
typedef unsigned u32x4 __attribute__((ext_vector_type(4)));
typedef unsigned u32x2 __attribute__((ext_vector_type(2)));
#define LAS __attribute__((address_space(3)))

__device__ __forceinline__ unsigned f2bf(float f) { unsigned u = __builtin_bit_cast(unsigned, f); return (u + 0x7fffu + ((u >> 16) & 1u)) >> 16; }
__device__ __forceinline__ unsigned pk2(float lo, float hi) { return f2bf(lo) | (f2bf(hi) << 16); }
__device__ __forceinline__ float bflo(unsigned w) { return __builtin_bit_cast(float, w << 16); }
__device__ __forceinline__ float bfhi(unsigned w) { return __builtin_bit_cast(float, w & 0xffff0000u); }
__device__ __forceinline__ float wave_sum(float v) {
#pragma unroll
    for (int o = 1; o < 64; o <<= 1) v += __shfl_xor(v, o);
    return v;
}
__device__ __forceinline__ int launder_tid() { int t = threadIdx.x; asm volatile("" : "+v"(t)); return t; }
__device__ __forceinline__ int wave_sum_i(int v) {
    v += __builtin_amdgcn_update_dpp(0, v, 0xB1, 0xf, 0xf, false);
    v += __builtin_amdgcn_update_dpp(0, v, 0x4E, 0xf, 0xf, false);
    v += __builtin_amdgcn_update_dpp(0, v, 0x141, 0xf, 0xf, false);
    v += __builtin_amdgcn_update_dpp(0, v, 0x140, 0xf, 0xf, false);
    return __builtin_amdgcn_readlane(v, 0) + __builtin_amdgcn_readlane(v, 16) + __builtin_amdgcn_readlane(v, 32) + __builtin_amdgcn_readlane(v, 48);
}
__device__ __forceinline__ int crow(int r, int hi) { return (r & 3) + 8 * (r >> 2) + 4 * hi; }

struct Params { const float* in[18]; float* out; unsigned char* ws; int ph_lo, ph_hi; };

__device__ __forceinline__ int dest_row(int n, int mode, int NH) {
    if (mode == 0) return n;
    if (mode == 1) { const int hf = n >= NH ? 1 : 0, nn = n - hf * NH; return (nn >> 7) * 256 + hf * 128 + (nn & 127); }
    if (n < 2048) return n;
    if (n < 2112) return COL_IK + (n - 2048);
    if (n < 2120) return COL_IW + (n - 2112);
    return COL_QB + (n - 2120);
}
__device__ __forceinline__ void transpose_item(const float* W, int K, int N, bf16* WT, int mode, LAS float* scr, int item, int lane) {
    const int nblk = (N + 31) / 32, kb = item / nblk, nb = item % nblk, k0 = 64 * kb, n0 = 32 * nb;
    const int nr = n0 + (lane & 31);
#pragma unroll 8
    for (int i = 0; i < 32; ++i) { const int kk = 2 * i + (lane >> 5); scr[kk * 33 + (lane & 31)] = nr < N ? W[(size_t)(k0 + kk) * N + nr] : 0.f; }
    asm volatile("s_waitcnt lgkmcnt(0)" ::: "memory");
    const int c = lane & 7;
#pragma unroll
    for (int j = 0; j < 4; ++j) { const int n = (lane >> 3) + 8 * j; const LAS float* s = scr + (8 * c) * 33 + n;
        u32x4 o; o.x = pk2(s[0 * 33], s[1 * 33]); o.y = pk2(s[2 * 33], s[3 * 33]); o.z = pk2(s[4 * 33], s[5 * 33]); o.w = pk2(s[6 * 33], s[7 * 33]);
        if (n0 + n < N) *(u32x4*)(WT + (size_t)dest_row(n0 + n, mode, N / 2) * K + k0 + 8 * c) = o; }
    asm volatile("s_waitcnt lgkmcnt(0)" ::: "memory");
}
__device__ __forceinline__ void prologue_phase(const Params& p, unsigned char* lds) {
    const int tid = launder_tid(), lane = tid & 63, wave = __builtin_amdgcn_readfirstlane(tid >> 6);
    LAS float* scr = (LAS float*)((LAS unsigned char*)lds + wave * 16384);
    const int gw = blockIdx.x * NWAVES + wave, NGW = gridDim.x * NWAVES;
    unsigned char* ws = p.ws;
    constexpr int I_FI = (1024 / 64) * (5632 / 32), I_FO = (2816 / 64) * (1024 / 32), I_MI = (1024 / 64) * ((PMIX + 31) / 32), I_SQ = (1024 / 64) * (1024 / 32), I_CI = (1024 / 64) * (2048 / 32);
    constexpr int T_FI = 8 * I_FI, T_FO = 8 * I_FO, T_MI = 2 * I_MI, T_MO = 2 * I_SQ, T_CI = 2 * I_CI, T_CO = 2 * I_SQ;
    constexpr int NITEMS = T_FI + T_FO + T_MI + T_MO + T_CI + T_CO;
    for (int it = gw; it < NITEMS; it += NGW) {
        int r = it;
        if (r < T_FI) { const int w = r / I_FI; transpose_item(p.in[1] + (size_t)w * 1024 * 5632, 1024, 5632, (bf16*)(ws + WS_WFI + w * SZ_WFI), 1, scr, r % I_FI, lane); continue; } r -= T_FI;
        if (r < T_FO) { const int w = r / I_FO; transpose_item(p.in[2] + (size_t)w * 2816 * 1024, 2816, 1024, (bf16*)(ws + WS_WFO + w * SZ_WFO), 0, scr, r % I_FO, lane); continue; } r -= T_FO;
        if (r < T_MI) { const int w = r / I_MI; transpose_item(p.in[6] + (size_t)w * 1024 * PMIX, 1024, PMIX, (bf16*)(ws + WS_WMI + w * SZ_WMI), 2, scr, r % I_MI, lane); continue; } r -= T_MI;
        if (r < T_MO) { const int w = r / I_SQ; transpose_item(p.in[11] + (size_t)w * 1024 * 1024, 1024, 1024, (bf16*)(ws + WS_WMO + w * SZ_WMO), 0, scr, r % I_SQ, lane); continue; } r -= T_MO;
        if (r < T_CI) { const int w = r / I_CI; transpose_item(p.in[12] + (size_t)w * 1024 * 2048, 1024, 2048, (bf16*)(ws + WS_WCI + w * SZ_WCI), 1, scr, r % I_CI, lane); continue; } r -= T_CI;
        { const int w = r / I_SQ; transpose_item(p.in[17] + (size_t)w * 1024 * 1024, 1024, 1024, (bf16*)(ws + WS_WCO + w * SZ_WCO), 0, scr, r % I_SQ, lane); }
    }
    const float* x = p.in[0]; bf16* xb = (bf16*)(ws + WS_XB);
    for (int m = gw; m < MTOK; m += NGW) {
        const f32x4* xr = (const f32x4*)(x + (size_t)m * DM) + lane; u32x2* o = (u32x2*)(xb + (size_t)m * DM) + lane;
#pragma unroll
        for (int j = 0; j < 4; ++j) { const f32x4 v = xr[64 * j]; u32x2 w; w.x = pk2(v.x, v.y); w.y = pk2(v.z, v.w); o[64 * j] = w; }
    }
}
__device__ __forceinline__ void ln_phase(const float* Y, const float* g, const float* bta, float* X, bf16* XB) {
    const int tid = launder_tid(), lane = tid & 63, wave = __builtin_amdgcn_readfirstlane(tid >> 6);
    const int gw = blockIdx.x * NWAVES + wave, NGW = gridDim.x * NWAVES;
    f32x4 gv[4], bv[4];
#pragma unroll
    for (int j = 0; j < 4; ++j) { gv[j] = ((const f32x4*)g)[lane + 64 * j]; bv[j] = ((const f32x4*)bta)[lane + 64 * j]; }
    for (int m = gw; m < MTOK; m += NGW) {
        const f32x4* yr = (const f32x4*)(Y + (size_t)m * DM) + lane;
        f32x4 v[4]; float s = 0.f;
#pragma unroll
        for (int j = 0; j < 4; ++j) { v[j] = yr[64 * j]; s += (v[j].x + v[j].y) + (v[j].z + v[j].w); }
        const float mean = wave_sum(s) * (1.f / DM); float s2 = 0.f;
#pragma unroll
        for (int j = 0; j < 4; ++j) { v[j] = v[j] - mean; s2 += (v[j].x * v[j].x + v[j].y * v[j].y) + (v[j].z * v[j].z + v[j].w * v[j].w); }
        const float rstd = 1.0f / sqrtf(wave_sum(s2) * (1.f / DM) + LN_EPS);
        f32x4* xo = (f32x4*)(X + (size_t)m * DM) + lane; u32x2* bo = (u32x2*)(XB + (size_t)m * DM) + lane;
#pragma unroll
        for (int j = 0; j < 4; ++j) { const f32x4 o = v[j] * rstd * gv[j] + bv[j]; xo[64 * j] = o; u32x2 w; w.x = pk2(o.x, o.y); w.y = pk2(o.z, o.w); bo[64 * j] = w; }
    }
}
__device__ __forceinline__ void ikln_phase(const bf16* P, const float* g, const float* bta, bf16* IK) {
    const int gt = blockIdx.x * NTHREADS + launder_tid(), NT = gridDim.x * NTHREADS;
    for (int m = gt; m < MTOK; m += NT) {
        const u32x4* src = (const u32x4*)(P + (size_t)m * PW + COL_IK);
        float v[64]; float s = 0.f;
#pragma unroll
        for (int c = 0; c < 8; ++c) { const u32x4 w = src[c];
            v[8 * c + 0] = bflo(w.x); v[8 * c + 1] = bfhi(w.x); v[8 * c + 2] = bflo(w.y); v[8 * c + 3] = bfhi(w.y);
            v[8 * c + 4] = bflo(w.z); v[8 * c + 5] = bfhi(w.z); v[8 * c + 6] = bflo(w.w); v[8 * c + 7] = bfhi(w.w); }
#pragma unroll
        for (int i = 0; i < 64; ++i) s += v[i];
        const float mean = s * (1.f / 64.f); float s2 = 0.f;
#pragma unroll
        for (int i = 0; i < 64; ++i) { v[i] -= mean; s2 += v[i] * v[i]; }
        const float rstd = 1.0f / sqrtf(s2 * (1.f / 64.f) + LN_EPS);
        u32x4* dst = (u32x4*)(IK + (size_t)m * 64);
#pragma unroll
        for (int c = 0; c < 8; ++c) { u32x4 w;
            w.x = pk2(v[8 * c + 0] * rstd * g[8 * c + 0] + bta[8 * c + 0], v[8 * c + 1] * rstd * g[8 * c + 1] + bta[8 * c + 1]);
            w.y = pk2(v[8 * c + 2] * rstd * g[8 * c + 2] + bta[8 * c + 2], v[8 * c + 3] * rstd * g[8 * c + 3] + bta[8 * c + 3]);
            w.z = pk2(v[8 * c + 4] * rstd * g[8 * c + 4] + bta[8 * c + 4], v[8 * c + 5] * rstd * g[8 * c + 5] + bta[8 * c + 5]);
            w.w = pk2(v[8 * c + 6] * rstd * g[8 * c + 6] + bta[8 * c + 6], v[8 * c + 7] * rstd * g[8 * c + 7] + bta[8 * c + 7]);
            dst[c] = w; }
    }
}
__device__ __forceinline__ void conv_phase(unsigned char* ldsg, const bf16* U, const float* dw, const float* dwb, const float* g, const float* bta, bf16* V) {
    const int tid = launder_tid(), lane = tid & 63, wave = __builtin_amdgcn_readfirstlane(tid >> 6);
    LAS f32x4* wl = (LAS f32x4*)ldsg;
    for (int i = tid; i < 31 * 256; i += NTHREADS) wl[i] = ((const f32x4*)dw)[i];
    __syncthreads();
    for (int chunk = blockIdx.x; chunk < MTOK / 64; chunk += gridDim.x) {
        const int mbase = chunk * 64 + wave * 8, tb = mbase & (SEQ - 1);
        f32x4 acc[8][4];
#pragma unroll
        for (int q = 0; q < 4; ++q) { const f32x4 cb = ((const f32x4*)dwb)[64 * q + lane];
#pragma unroll
            for (int rr = 0; rr < 8; ++rr) acc[rr][q] = cb; }
        const int i0 = tb >= 30 ? 0 : 30 - tb;
        const u32x2* ubase = (const u32x2*)(U + (size_t)(mbase - 30) * DM) + lane;
        u32x2 un[4];
#pragma unroll
        for (int q = 0; q < 4; ++q) un[q] = ubase[(size_t)i0 * (DM / 4) + 64 * q];
#pragma unroll 1
        for (int i = i0; i < 38; ++i) {
            u32x2 uc[4];
#pragma unroll
            for (int q = 0; q < 4; ++q) uc[q] = un[q];
            if (i + 1 < 38) {
#pragma unroll
                for (int q = 0; q < 4; ++q) un[q] = ubase[(size_t)(i + 1) * (DM / 4) + 64 * q];
            }
            f32x4 uf[4];
#pragma unroll
            for (int q = 0; q < 4; ++q) { uf[q].x = bflo(uc[q].x); uf[q].y = bfhi(uc[q].x); uf[q].z = bflo(uc[q].y); uf[q].w = bfhi(uc[q].y); }
#pragma unroll
            for (int rr = 0; rr < 8; ++rr) {
                const int j = i - rr;
                if (j >= 0 && j <= 30) {
#pragma unroll
                    for (int q = 0; q < 4; ++q) acc[rr][q] += uf[q] * wl[j * 256 + 64 * q + lane];
                }
            }
        }
        f32x4 gv[4], bv[4];
#pragma unroll
        for (int q = 0; q < 4; ++q) { gv[q] = ((const f32x4*)g)[64 * q + lane]; bv[q] = ((const f32x4*)bta)[64 * q + lane]; }
#pragma unroll
        for (int rr = 0; rr < 8; ++rr) {
            float sm = 0.f;
#pragma unroll
            for (int q = 0; q < 4; ++q) sm += (acc[rr][q].x + acc[rr][q].y) + (acc[rr][q].z + acc[rr][q].w);
            const float mean = wave_sum(sm) * (1.f / DM); float s2 = 0.f;
#pragma unroll
            for (int q = 0; q < 4; ++q) { acc[rr][q] = acc[rr][q] - mean; s2 += (acc[rr][q].x * acc[rr][q].x + acc[rr][q].y * acc[rr][q].y) + (acc[rr][q].z * acc[rr][q].z + acc[rr][q].w * acc[rr][q].w); }
            const float rstd = 1.0f / sqrtf(wave_sum(s2) * (1.f / DM) + LN_EPS);
            u32x2* vrow = (u32x2*)(V + (size_t)(mbase + rr) * DM) + lane;
#pragma unroll
            for (int q = 0; q < 4; ++q) { const f32x4 y = acc[rr][q] * rstd * gv[q] + bv[q];
                u32x2 w; w.x = pk2(y.x * pg8::sigmoidf_fast(y.x), y.y * pg8::sigmoidf_fast(y.y)); w.y = pk2(y.z * pg8::sigmoidf_fast(y.z), y.w * pg8::sigmoidf_fast(y.w)); vrow[64 * q] = w; }
        }
    }
    __syncthreads();
}
__device__ __forceinline__ int t5_bucket(int n) {
    if (n < 16) return n;
    int v = 16 + (int)(logf((float)n / 16.0f) / logf(8.0f) * 16.0f);
    return v < 31 ? v : 31;
}
__device__ __forceinline__ unsigned cvtpk(float lo, float hi) { typedef float f2 __attribute__((ext_vector_type(2))); typedef __bf16 b2 __attribute__((ext_vector_type(2))); f2 v = {lo, hi}; b2 b = __builtin_convertvector(v, b2); return __builtin_bit_cast(unsigned, b); }
__device__ __forceinline__ bf16x8 pack8(const f32x16& x, int s) {
    u32x4 p; p.x = cvtpk(x[8 * s + 0], x[8 * s + 1]); p.y = cvtpk(x[8 * s + 2], x[8 * s + 3]); p.z = cvtpk(x[8 * s + 4], x[8 * s + 5]); p.w = cvtpk(x[8 * s + 6], x[8 * s + 7]);
    return __builtin_bit_cast(bf16x8, p);
}
typedef short v4i16_t __attribute__((ext_vector_type(4)));
__device__ __forceinline__ s16x4 vtr(const LAS unsigned char* p) { return __builtin_bit_cast(s16x4, __builtin_amdgcn_ds_read_tr16_b64_v4i16((LAS v4i16_t*)p)); }

__device__ __forceinline__ void diff_unit(unsigned char* ldsg, const bf16* P, bf16* O, int b, int h, int qb, float lam_full, float oscale, const float* subg) {
    LAS unsigned char* lds = (LAS unsigned char*)ldsg;
    const int tid = launder_tid(), lane = tid & 63, wid = __builtin_amdgcn_readfirstlane(tid >> 6), r32 = lane & 31, hi = lane >> 5;
    const int map = wid >> 2, qs = wid & 3;
    const int q0 = qb * 128, qmin = q0 + qs * 32, myq = qmin + r32;
    const size_t rowbase = (size_t)b * SEQ;
    constexpr int RS = 272, TILE = 64 * RS;
    LAS float* wsf = (LAS float*)(lds + 4 * TILE) + wid * 32;
    const LAS float* lut = (const LAS float*)(lds + LDS_LUT) + (8 + h) * 129;
    bf16x8 qr[4];
    { const bf16* qp = P + (rowbase + myq) * PW + COL_QB + h * 128 + map * 64 + hi * 8;
#pragma unroll
      for (int d0 = 0; d0 < 4; ++d0) qr[d0] = *(const bf16x8*)(qp + d0 * 16); }
    const int NT = 2 * qb + 2;
    f32x16 o[4];
#pragma unroll
    for (int d = 0; d < 4; ++d)
#pragma unroll
        for (int i = 0; i < 16; ++i) o[d][i] = 0.f;
    float mrun = -INFINITY, lrun = 0.f;
    const float SC = 0.125f * LOG2E;
    const int lrow0 = tid >> 4, lc16 = tid & 15;
    const bf16* kg = P + (rowbase + lrow0) * PW + COL_KB + h * 128 + lc16 * 8;
    const bf16* vg = P + (rowbase + lrow0) * PW + COL_VB + h * 128 + lc16 * 8;
    u32x4 kr[2], vr[2];
#pragma unroll
    for (int i = 0; i < 2; ++i) { kr[i] = *(const u32x4*)(kg + (size_t)(32 * i) * PW); vr[i] = *(const u32x4*)(vg + (size_t)(32 * i) * PW); }
    const int q4 = (lane & 15) >> 2;
    const int vcol = (16 * ((lane >> 4) & 1) + 4 * (lane & 3)) * 2;
    for (int t = 0; t < NT; ++t) {
        const int buf = t & 1;
        LAS unsigned char* Kb = lds + buf * TILE; LAS unsigned char* Vb = lds + (2 + buf) * TILE;
#pragma unroll
        for (int i = 0; i < 2; ++i) { *(LAS u32x4*)(Kb + (lrow0 + 32 * i) * RS + lc16 * 16) = kr[i]; *(LAS u32x4*)(Vb + (lrow0 + 32 * i) * RS + lc16 * 16) = vr[i]; }
        __syncthreads();
        if (t + 1 < NT) {
#pragma unroll
            for (int i = 0; i < 2; ++i) { kr[i] = *(const u32x4*)(kg + (size_t)(64 * (t + 1) + 32 * i) * PW); vr[i] = *(const u32x4*)(vg + (size_t)(64 * (t + 1) + 32 * i) * PW); }
        }
        const int kb0 = 64 * t;
        if (kb0 > qmin + 31) continue;
        f32x16 p0, p1;
#pragma unroll
        for (int i = 0; i < 16; ++i) { p0[i] = 0.f; p1[i] = 0.f; }
#pragma unroll
        for (int d0 = 0; d0 < 4; ++d0) {
            const bf16x8 a0 = *(const LAS bf16x8*)(Kb + r32 * RS + (map * 64 + d0 * 16 + hi * 8) * 2);
            const bf16x8 a1 = *(const LAS bf16x8*)(Kb + (32 + r32) * RS + (map * 64 + d0 * 16 + hi * 8) * 2);
            p0 = __builtin_amdgcn_mfma_f32_32x32x16_bf16(a0, qr[d0], p0, 0, 0, 0);
            p1 = __builtin_amdgcn_mfma_f32_32x32x16_bf16(a1, qr[d0], p1, 0, 0, 0);
        }
        if (qmin - (kb0 + 63) >= 128) {
            const float c = lut[128];
#pragma unroll
            for (int i = 0; i < 16; ++i) { p0[i] = p0[i] * SC + c; p1[i] = p1[i] * SC + c; }
        } else {
#pragma unroll
            for (int i = 0; i < 16; ++i) {
                const int n0 = myq - (kb0 + crow(i, hi)), n1 = n0 - 32;
                const float b0 = lut[n0 < 0 ? 0 : (n0 > 128 ? 128 : n0)], b1 = lut[n1 < 0 ? 0 : (n1 > 128 ? 128 : n1)];
                p0[i] = n0 < 0 ? -INFINITY : p0[i] * SC + b0; p1[i] = n1 < 0 ? -INFINITY : p1[i] * SC + b1;
            }
        }
        float rm = fmaxf(p0[0], p1[0]);
#pragma unroll
        for (int i = 1; i < 16; ++i) rm = fmaxf(rm, fmaxf(p0[i], p1[i]));
        rm = fmaxf(rm, __shfl_xor(rm, 32));
        const float mnew = fmaxf(mrun, rm);
        const float f = __builtin_amdgcn_exp2f(mrun - mnew);
        mrun = mnew;
        float ls = 0.f;
#pragma unroll
        for (int i = 0; i < 16; ++i) { p0[i] = __builtin_amdgcn_exp2f(p0[i] - mnew); p1[i] = __builtin_amdgcn_exp2f(p1[i] - mnew); ls += p0[i] + p1[i]; }
        lrun = lrun * f + ls;
        if (__any(f != 1.0f)) {
            if (hi == 0) wsf[r32] = f;
            __builtin_amdgcn_wave_barrier();
#pragma unroll
            for (int i = 0; i < 16; ++i) { const float fi = wsf[crow(i, hi)];
#pragma unroll
                for (int d = 0; d < 4; ++d) o[d][i] *= fi; }
            __builtin_amdgcn_wave_barrier();
        }
        bf16x8 pa[4]; pa[0] = pack8(p0, 0); pa[1] = pack8(p0, 1); pa[2] = pack8(p1, 0); pa[3] = pack8(p1, 1);
#pragma unroll
        for (int d0 = 0; d0 < 4; ++d0)
#pragma unroll
            for (int ks = 0; ks < 4; ++ks) {
                const LAS unsigned char* vp = Vb + (16 * ks + 4 * hi + q4) * RS + d0 * 64 + vcol;
                const s16x4 lo = vtr(vp), hh = vtr(vp + 8 * RS);
                const bf16x8 vf = __builtin_shufflevector(lo, hh, 0, 1, 2, 3, 4, 5, 6, 7);
                o[d0] = __builtin_amdgcn_mfma_f32_32x32x16_bf16(pa[ks], vf, o[d0], 0, 0, 0);
            }
    }
    lrun += __shfl_xor(lrun, 32);
    if (hi == 0) wsf[r32] = 1.0f / lrun;
    __builtin_amdgcn_wave_barrier();
#pragma unroll
    for (int i = 0; i < 16; ++i) { const float fi = wsf[crow(i, hi)];
#pragma unroll
        for (int d = 0; d < 4; ++d) o[d][i] *= fi; }
    __syncthreads();
    LAS float* X = (LAS float*)lds;
    if (map == 1) {
#pragma unroll
        for (int d = 0; d < 4; ++d)
#pragma unroll
            for (int i = 0; i < 16; ++i) X[(qs * 32 + crow(i, hi)) * 128 + 32 * d + r32] = o[d][i];
    }
    __syncthreads();
    if (map == 0) {
        float gsub[4];
#pragma unroll
        for (int d = 0; d < 4; ++d) gsub[d] = subg[32 * d + r32];
#pragma unroll
        for (int i = 0; i < 16; ++i) {
            float ss = 0.f;
#pragma unroll
            for (int d = 0; d < 4; ++d) { const float v = o[d][i] - lam_full * X[(qs * 32 + crow(i, hi)) * 128 + 32 * d + r32]; o[d][i] = v; ss += v * v; }
#pragma unroll
            for (int sft = 1; sft < 32; sft <<= 1) ss += __shfl_xor(ss, sft);
            const float rs = (1.0f / sqrtf(ss * (1.f / 128.f) + LN_EPS)) * oscale;
            bf16* orow = O + (rowbase + qmin + crow(i, hi)) * DM + 512 + h * 128 + r32;
#pragma unroll
            for (int d = 0; d < 4; ++d) orow[32 * d] = (bf16)f2bf(o[d][i] * rs * gsub[d]);
        }
    }
    __syncthreads();
}

__device__ __forceinline__ void cnt_ge2(int& a0, int& a1, unsigned k0, unsigned k1, unsigned c) {
    unsigned long long m;
    asm volatile("v_cmp_ge_u32_e32 vcc, %3, %5\n\tv_cmp_ge_u32_e64 %2, %4, %5\n\ts_nop 0\n\tv_addc_co_u32_e32 %0, vcc, 0, %0, vcc\n\tv_addc_co_u32_e64 %1, %2, 0, %1, %2"
                 : "+v"(a0), "+v"(a1), "=&s"(m) : "v"(k0), "v"(k1), "v"(c) : "vcc");
}
template <int NREG>
__device__ __forceinline__ void select_query(const float* row, int t, int lane, unsigned long long* brow64) {
    unsigned k[NREG];
#pragma unroll
    for (int r = 0; r < NREG; ++r) k[r] = __builtin_bit_cast(unsigned, row[r * 64 + lane]);
#pragma unroll
    for (int r = 0; r < NREG; ++r) {
        const unsigned u = k[r]; unsigned key = u ^ ((unsigned)((int)u >> 31) | 0x80000000u);
        const int tl = t - r * 64;
        if (tl < 63) asm volatile("v_cmp_lt_i32_e32 vcc, %1, %2\n\ts_nop 1\n\tv_cndmask_b32_e64 %0, %0, 0, vcc" : "+v"(key) : "s"(tl), "v"(lane) : "vcc");
        k[r] = key;
    }
    unsigned pth = 1u, ptie = 0u; int need = 0, cgt = 0;
    if (t >= 256) {
        pth = 0u; int cntge = 0;
        for (int bit = 31; bit >= 0; --bit) {
            const unsigned c = pth | (1u << bit);
            int c0 = 0, c1 = 0;
#pragma unroll
            for (int r = 0; r < NREG; r += 2) cnt_ge2(c0, c1, k[r], k[r + 1], c);
            const int cnt = wave_sum_i(c0 + c1);
            if (cnt >= 256) { pth = c; cntge = cnt; }
            if (cnt == 256) break;
        }
        if (cntge != 256) {
            int c0 = 0, c1 = 0;
#pragma unroll
            for (int r = 0; r < NREG; r += 2) cnt_ge2(c0, c1, k[r], k[r + 1], pth + 1u);
            cgt = wave_sum_i(c0 + c1); need = 256 - cgt; ptie = pth; pth = pth + 1u;
        }
    }
    {
        unsigned w0lo = 0u, w0hi = 0u, w1lo = 0u, w1hi = 0u;
#define WL1(r) { if constexpr ((r) < NREG) { const unsigned long long m0 = __ballot(k[(r) < NREG ? (r) : 0] >= pth); \
                asm volatile("s_nop 1\n\tv_writelane_b32 %0, %1, " #r : "+v"(w0lo) : "s"((unsigned)m0)); asm volatile("v_writelane_b32 %0, %1, " #r : "+v"(w0hi) : "s"((unsigned)(m0 >> 32))); } \
            if constexpr ((r) + 64 < NREG) { const unsigned long long m1 = __ballot(k[(r) + 64 < NREG ? (r) + 64 : 0] >= pth); \
                asm volatile("s_nop 1\n\tv_writelane_b32 %0, %1, " #r : "+v"(w1lo) : "s"((unsigned)m1)); asm volatile("v_writelane_b32 %0, %1, " #r : "+v"(w1hi) : "s"((unsigned)(m1 >> 32))); } \
            __builtin_amdgcn_sched_barrier(0); }
        WL1(0) WL1(1) WL1(2) WL1(3) WL1(4) WL1(5) WL1(6) WL1(7) WL1(8) WL1(9)
        WL1(10) WL1(11) WL1(12) WL1(13) WL1(14) WL1(15) WL1(16) WL1(17) WL1(18) WL1(19)
        WL1(20) WL1(21) WL1(22) WL1(23) WL1(24) WL1(25) WL1(26) WL1(27) WL1(28) WL1(29)
        WL1(30) WL1(31) WL1(32) WL1(33) WL1(34) WL1(35) WL1(36) WL1(37) WL1(38) WL1(39)
        WL1(40) WL1(41) WL1(42) WL1(43) WL1(44) WL1(45) WL1(46) WL1(47) WL1(48) WL1(49)
        WL1(50) WL1(51) WL1(52) WL1(53) WL1(54) WL1(55) WL1(56) WL1(57) WL1(58) WL1(59)
        WL1(60) WL1(61) WL1(62) WL1(63)
#undef WL1
        u32x2* brow = (u32x2*)brow64;
        u32x2 v0; v0.x = w0lo; v0.y = w0hi; u32x2 v1; v1.x = w1lo; v1.y = w1hi;
        brow[lane] = v0; brow[64 + lane] = v1;
    }
    if (need > 0) {
        asm volatile("s_waitcnt vmcnt(0)" ::: "memory");
        int filled = 0;
#pragma unroll 1
        for (int r = 0; r * 64 <= t && filled < need; ++r) {
            const int s = r * 64 + lane; unsigned key = 0u;
            if (s <= t) { const unsigned u = __builtin_bit_cast(unsigned, row[s]); key = (u & 0x80000000u) ? ~u : (u | 0x80000000u); }
            const bool eq = key == ptie;
            const unsigned long long me = __ballot(eq);
            const int pe = filled + (int)__builtin_amdgcn_mbcnt_hi((unsigned)(me >> 32), __builtin_amdgcn_mbcnt_lo((unsigned)me, 0u));
            const unsigned long long take = __ballot(eq && pe < need);
            if (lane == 0 && take != 0ull) atomicOr(brow64 + r, take);
            filled += __popcll(me);
        }
    }
}
__device__ __forceinline__ void dsa_unit(unsigned char* ldsg, const bf16* P, const bf16* IK, unsigned long long* bits, float* scr, int b, int t0) {
    LAS unsigned char* lds = (LAS unsigned char*)ldsg;
    const int tid = launder_tid(), lane = tid & 63, wid = __builtin_amdgcn_readfirstlane(tid >> 6);
    const size_t rowbase = (size_t)b * SEQ;
    {
        const int c16 = lane & 15, g4 = lane >> 4;
        const bf16* qrow = P + (rowbase + t0 + c16) * PW;
        bf16x8 bq[8][2];
#pragma unroll
        for (int hh = 0; hh < 8; ++hh)
#pragma unroll
            for (int ks = 0; ks < 2; ++ks) bq[hh][ks] = *(const bf16x8*)(qrow + COL_IQ + hh * 64 + ks * 32 + 8 * g4);
        float w[8];
        { const u32x4 wv = *(const u32x4*)(qrow + COL_IW); w[0] = bflo(wv.x); w[1] = bfhi(wv.x); w[2] = bflo(wv.y); w[3] = bfhi(wv.y); w[4] = bflo(wv.z); w[5] = bfhi(wv.z); w[6] = bflo(wv.w); w[7] = bfhi(wv.w); }
        const int nkt = t0 / 16 + 1;
        for (int kt0 = wid; kt0 < nkt; kt0 += 4 * NWAVES) {
            bf16x8 a0[4], a1[4];
#pragma unroll
            for (int u = 0; u < 4; ++u) { int kt = kt0 + u * NWAVES; kt = kt < nkt ? kt : nkt - 1;
                const bf16* krow = IK + (rowbase + 16 * kt + c16) * 64 + 8 * g4; a0[u] = *(const bf16x8*)krow; a1[u] = *(const bf16x8*)(krow + 32); }
#pragma unroll
            for (int u = 0; u < 4; ++u) {
                const int kt = kt0 + u * NWAVES;
                f32x4 sc = {0.f, 0.f, 0.f, 0.f};
#pragma unroll
                for (int hh = 0; hh < 8; ++hh) {
                    f32x4 z = {0.f, 0.f, 0.f, 0.f};
                    z = __builtin_amdgcn_mfma_f32_16x16x32_bf16(a0[u], bq[hh][0], z, 0, 0, 0);
                    z = __builtin_amdgcn_mfma_f32_16x16x32_bf16(a1[u], bq[hh][1], z, 0, 0, 0);
#pragma unroll
                    for (int e = 0; e < 4; ++e) sc[e] += w[hh] * fmaxf(z[e], 0.f);
                }
                if (kt < nkt) *(f32x4*)(scr + (size_t)c16 * SEQ + 16 * kt + 4 * g4) = sc;
            }
        }
    }
    __syncthreads();
    __builtin_amdgcn_fence(__ATOMIC_ACQUIRE, "agent");
    for (int qq = wid; qq < 16; qq += NWAVES) {
        const int t = t0 + qq;
        const float* row = scr + (size_t)qq * SEQ;
        unsigned long long* brow64 = bits + (rowbase + t) * 128;
        const int nch = (t >> 6) + 1;
        if (nch <= 32) select_query<32>(row, t, lane, brow64);
        else if (nch <= 64) select_query<64>(row, t, lane, brow64);
        else if (nch <= 96) select_query<96>(row, t, lane, brow64);
        else select_query<128>(row, t, lane, brow64);
    }
    __syncthreads();
}

__device__ __forceinline__ void dsa_attn_unit(unsigned char* ldsg, const bf16* P, const unsigned long long* bits, bf16* O, int b, int h, int qb) {
    LAS unsigned char* lds = (LAS unsigned char*)ldsg;
    const int tid = launder_tid(), lane = tid & 63, wid = __builtin_amdgcn_readfirstlane(tid >> 6), r32 = lane & 31, hi = lane >> 5;
    const int q0 = qb * 256, qmin = q0 + wid * 32, myq = qmin + r32;
    const size_t rowbase = (size_t)b * SEQ;
    constexpr int RS = 144, TILE = 64 * RS;
    LAS float* wsf = (LAS float*)(lds + 4 * TILE) + wid * 32;
    const LAS float* lut = (const LAS float*)(lds + LDS_LUT) + h * 129;
    bf16x8 qr[4];
    { const bf16* qp = P + (rowbase + myq) * PW + COL_QA + h * 64 + hi * 8;
#pragma unroll
      for (int d0 = 0; d0 < 4; ++d0) qr[d0] = *(const bf16x8*)(qp + d0 * 16); }
    const int NT = 4 * qb + 4;
    f32x16 o[2];
#pragma unroll
    for (int d = 0; d < 2; ++d)
#pragma unroll
        for (int i = 0; i < 16; ++i) o[d][i] = 0.f;
    float mrun = -INFINITY, lrun = 0.f;
    const float SC = 0.125f * LOG2E;
    const int lrow = tid >> 3, lc16 = tid & 7;
    const bf16* kg = P + (rowbase + lrow) * PW + COL_KA + h * 64 + lc16 * 8;
    const bf16* vg = P + (rowbase + lrow) * PW + COL_VA + h * 64 + lc16 * 8;
    u32x4 kr = *(const u32x4*)kg, vr = *(const u32x4*)vg;
    const u32x2* brow = (const u32x2*)(bits + (rowbase + myq) * 128);
    u32x2 wnext = brow[0];
    const int q4 = (lane & 15) >> 2;
    const int vcol = (16 * ((lane >> 4) & 1) + 4 * (lane & 3)) * 2;
    for (int t = 0; t < NT; ++t) {
        const int buf = t & 1;
        LAS unsigned char* Kb = lds + buf * TILE; LAS unsigned char* Vb = lds + (2 + buf) * TILE;
        *(LAS u32x4*)(Kb + lrow * RS + lc16 * 16) = kr; *(LAS u32x4*)(Vb + lrow * RS + lc16 * 16) = vr;
        __syncthreads();
        const u32x2 w = wnext;
        if (t + 1 < NT) { kr = *(const u32x4*)(kg + (size_t)(64 * (t + 1)) * PW); vr = *(const u32x4*)(vg + (size_t)(64 * (t + 1)) * PW); wnext = brow[t + 1]; }
        const int kb0 = 64 * t;
        if (kb0 > qmin + 31) continue;
        if (!__any((w.x | w.y) != 0u)) continue;
        f32x16 p0, p1;
#pragma unroll
        for (int i = 0; i < 16; ++i) { p0[i] = 0.f; p1[i] = 0.f; }
#pragma unroll
        for (int d0 = 0; d0 < 4; ++d0) {
            const bf16x8 a0 = *(const LAS bf16x8*)(Kb + r32 * RS + (d0 * 16 + hi * 8) * 2);
            const bf16x8 a1 = *(const LAS bf16x8*)(Kb + (32 + r32) * RS + (d0 * 16 + hi * 8) * 2);
            p0 = __builtin_amdgcn_mfma_f32_32x32x16_bf16(a0, qr[d0], p0, 0, 0, 0);
            p1 = __builtin_amdgcn_mfma_f32_32x32x16_bf16(a1, qr[d0], p1, 0, 0, 0);
        }
        const unsigned wl = w.x >> (4 * hi), wh = w.y >> (4 * hi);
        if (qmin - (kb0 + 63) >= 128) {
            const float c = lut[128];
#pragma unroll
            for (int i = 0; i < 16; ++i) { const unsigned bm = 1u << ((i & 3) + 8 * (i >> 2));
                p0[i] = (wl & bm) ? p0[i] * SC + c : -INFINITY; p1[i] = (wh & bm) ? p1[i] * SC + c : -INFINITY; }
        } else {
#pragma unroll
            for (int i = 0; i < 16; ++i) { const unsigned bm = 1u << ((i & 3) + 8 * (i >> 2));
                const int n0 = myq - (kb0 + crow(i, hi)), n1 = n0 - 32;
                const float b0 = lut[n0 < 0 ? 0 : (n0 > 128 ? 128 : n0)], b1 = lut[n1 < 0 ? 0 : (n1 > 128 ? 128 : n1)];
                p0[i] = (wl & bm) ? p0[i] * SC + b0 : -INFINITY; p1[i] = (wh & bm) ? p1[i] * SC + b1 : -INFINITY; }
        }
        float rm = fmaxf(p0[0], p1[0]);
#pragma unroll
        for (int i = 1; i < 16; ++i) rm = fmaxf(rm, fmaxf(p0[i], p1[i]));
        rm = fmaxf(rm, __shfl_xor(rm, 32));
        const float mnew = fmaxf(mrun, rm);
        const float msafe = (mnew == -INFINITY) ? 0.f : mnew;
        const float f = (mrun == -INFINITY) ? 1.0f : __builtin_amdgcn_exp2f(mrun - msafe);
        mrun = mnew;
        float ls = 0.f;
#pragma unroll
        for (int i = 0; i < 16; ++i) { p0[i] = __builtin_amdgcn_exp2f(p0[i] - msafe); p1[i] = __builtin_amdgcn_exp2f(p1[i] - msafe); ls += p0[i] + p1[i]; }
        lrun = lrun * f + ls;
        if (__any(f != 1.0f)) {
            if (hi == 0) wsf[r32] = f;
            __builtin_amdgcn_wave_barrier();
#pragma unroll
            for (int i = 0; i < 16; ++i) { const float fi = wsf[crow(i, hi)]; o[0][i] *= fi; o[1][i] *= fi; }
            __builtin_amdgcn_wave_barrier();
        }
        bf16x8 pa[4]; pa[0] = pack8(p0, 0); pa[1] = pack8(p0, 1); pa[2] = pack8(p1, 0); pa[3] = pack8(p1, 1);
#pragma unroll
        for (int d0 = 0; d0 < 2; ++d0)
#pragma unroll
            for (int ks = 0; ks < 4; ++ks) {
                const LAS unsigned char* vp = Vb + (16 * ks + 4 * hi + q4) * RS + d0 * 64 + vcol;
                const s16x4 lo = vtr(vp), hh = vtr(vp + 8 * RS);
                const bf16x8 vf = __builtin_shufflevector(lo, hh, 0, 1, 2, 3, 4, 5, 6, 7);
                o[d0] = __builtin_amdgcn_mfma_f32_32x32x16_bf16(pa[ks], vf, o[d0], 0, 0, 0);
            }
    }
    lrun += __shfl_xor(lrun, 32);
    if (hi == 0) wsf[r32] = 1.0f / lrun;
    __builtin_amdgcn_wave_barrier();
#pragma unroll
    for (int i = 0; i < 16; ++i) { const float fi = wsf[crow(i, hi)];
        bf16* orow = O + (rowbase + qmin + crow(i, hi)) * DM + h * 64 + r32;
        orow[0] = (bf16)f2bf(o[0][i] * fi); orow[32] = (bf16)f2bf(o[1][i] * fi); }
    __syncthreads();
}

__device__ __forceinline__ void att_phase(const Params& p, unsigned char* ldsg, int layer) {
    const int tid = launder_tid();
    const int j = layer >> 1;
    unsigned char* ws = p.ws;
    const bf16* P = (const bf16*)(ws + WS_PB); const bf16* IK = (const bf16*)(ws + WS_IK); bf16* O = (bf16*)(ws + WS_XB);
    float* scr = (float*)(ws + WS_SCR) + (size_t)blockIdx.x * 16 * SEQ;
    LAS float* lut = (LAS float*)((LAS unsigned char*)ldsg + LDS_LUT);
    LAS float* misc = lut + 12 * 129;
    const float* relb = p.in[5];
    for (int i = tid; i < 12 * 129; i += NTHREADS) { const int hd = i / 129, n = i % 129; lut[i] = relb[t5_bucket(n) * 12 + hd] * LOG2E; }
    if (tid < 64) {
        const float* lam = p.in[9] + (size_t)j * 4 * 64;
        const float a = wave_sum(lam[tid] * lam[64 + tid]), bb = wave_sum(lam[128 + tid] * lam[192 + tid]);
        if (tid == 0) misc[0] = a, misc[1] = bb;
    }
    __syncthreads();
    const float lam_init = 0.8f - 0.6f * expf(-0.3f * (float)layer);
    const float lam_full = expf(misc[0]) - expf(misc[1]) + lam_init;
    const float* subg = p.in[10] + (size_t)j * 128;
    for (int rep = 0; rep < DUP_DIFF; ++rep)
    for (int c = blockIdx.x; c < 256; c += gridDim.x) {
        const int b = c >> 7, h = (c >> 5) & 3, i = c & 31;
        if (EN_DIFF) diff_unit(ldsg, P, O, b, h, 63 - i, lam_full, 1.0f - lam_init, subg);
        if (EN_DIFF) diff_unit(ldsg, P, O, b, h, i, lam_full, 1.0f - lam_init, subg);
    }
    unsigned long long* bits = (unsigned long long*)(ws + WS_BITS);
    for (int rep = 0; rep < DUP_DSA; ++rep)
    for (int c = blockIdx.x; c < 256; c += gridDim.x) {
#pragma unroll 1
        for (int kq = 0; kq < 4; ++kq) {
            const int id = (kq == 0) ? 1023 - c : (kq == 1) ? 512 + c : (kq == 2) ? 511 - c : c;
            if (EN_DSA) dsa_unit(ldsg, P, IK, bits, scr, id & 1, (id >> 1) * 16);
        }
    }
}
__device__ __forceinline__ void attb_phase(const Params& p, unsigned char* ldsg) {
    const int tid = launder_tid();
    unsigned char* ws = p.ws;
    const bf16* P = (const bf16*)(ws + WS_PB); bf16* O = (bf16*)(ws + WS_XB);
    const unsigned long long* bits = (const unsigned long long*)(ws + WS_BITS);
    LAS float* lut = (LAS float*)((LAS unsigned char*)ldsg + LDS_LUT);
    const float* relb = p.in[5];
    for (int i = tid; i < 8 * 129; i += NTHREADS) { const int hd = i / 129, n = i % 129; lut[i] = relb[t5_bucket(n) * 12 + hd] * LOG2E; }
    __syncthreads();
    for (int rep = 0; rep < DUP_ATTB; ++rep)
    for (int c = blockIdx.x; c < 256; c += gridDim.x) {
        const int b = c >> 7, h = (c >> 4) & 7, i = c & 15;
        dsa_attn_unit(ldsg, P, bits, O, b, h, 31 - i);
        dsa_attn_unit(ldsg, P, bits, O, b, h, i);
    }
}

#define XB_TMO      128
#define XB_XCNT(j)  (256  + 64 * (j))
#define XB_XSUB(j)  (1280 + 64 * (j))
#define XB_XGEN(j)  (2304 + 64 * (j))
#define XB_TOP      3328
#define XB_TOPGEN   3392
#define XCD_BAR_WORDS 3456
#define XB_SPIN_CAP (1u << 18)

__device__ __forceinline__ unsigned xb_ld(unsigned* p)              { return __hip_atomic_load(p, __ATOMIC_RELAXED, __HIP_MEMORY_SCOPE_AGENT); }
__device__ __forceinline__ unsigned xb_add(unsigned* p, unsigned v) { return __hip_atomic_fetch_add(p, v, __ATOMIC_RELAXED, __HIP_MEMORY_SCOPE_AGENT); }
__device__ __forceinline__ unsigned xb_xcc_id() { return (unsigned)__builtin_amdgcn_s_getreg((3 << 11) | 20) & 0xFu; }
#define XB_SPIN(cond, bar) do { unsigned _sp = 0; while (cond) { __builtin_amdgcn_s_sleep(1); \
    if ((++_sp & 255u) == 0u) { if (xb_ld(&(bar)[XB_TMO])) break; if (_sp > XB_SPIN_CAP) { atomicAdd(&(bar)[XB_TMO], 1u); break; } } } } while (0)

struct XcdBarrier {
    unsigned* bar; unsigned x;
    volatile LAS unsigned* st;
};

__device__ __forceinline__ XcdBarrier xcd_barrier_post(unsigned* bar, volatile LAS unsigned* st) {
    XcdBarrier b; b.bar = bar; b.x = xb_xcc_id(); b.st = st;
    if (threadIdx.x == 0) (void)xb_add(&bar[XB_XCNT(b.x)], 1u);
    return b;
}
__device__ __forceinline__ void xcd_barrier_complete(unsigned* bar, unsigned x, unsigned& nloc, unsigned& nx) {
    const unsigned G = gridDim.x * gridDim.y * gridDim.z;
    unsigned sum, cnt, mine, sp = 0u;
    for (;;) {
        sum = 0u; cnt = 0u; mine = 0u;
#pragma unroll
        for (unsigned j = 0; j < 16; ++j) { const unsigned c = xb_ld(&bar[XB_XCNT(j)]); sum += c; cnt += (c > 0u) ? 1u : 0u; mine = (j == x) ? c : mine; }
        if (sum == G) break;
        __builtin_amdgcn_s_sleep(1);
        if ((++sp & 255u) == 0u) { if (xb_ld(&bar[XB_TMO])) break; if (sp > XB_SPIN_CAP) { atomicAdd(&bar[XB_TMO], 1u); break; } }
    }
    nloc = mine > 0u ? mine : 1u; nx = cnt > 0u ? cnt : 1u;
}

__device__ __forceinline__ void xcd_barrier(const XcdBarrier& b) {
    asm volatile("s_waitcnt vmcnt(0)" ::: "memory");
    __syncthreads();
    if (threadIdx.x == 0) {
        unsigned* bar = b.bar;
        __builtin_amdgcn_s_waitcnt(0);
        unsigned nloc = b.st[0], nx = b.st[1];
        if (nloc == 0u) { xcd_barrier_complete(bar, b.x, nloc, nx); b.st[0] = nloc; b.st[1] = nx; }
        const unsigned old = xb_add(&bar[XB_XSUB(b.x)], 1u);
        const unsigned gen = old / nloc;
        if (old + 1u == (gen + 1u) * nloc) {
            __builtin_amdgcn_fence(__ATOMIC_RELEASE, "agent");
            asm volatile("s_waitcnt vmcnt(0)" ::: "memory");
            const unsigned og = xb_add(&bar[XB_TOP], 1u);
            const unsigned tg = og / nx;
            if (og + 1u == (tg + 1u) * nx) xb_add(&bar[XB_TOPGEN], 1u);
            else XB_SPIN(xb_ld(&bar[XB_TOPGEN]) == tg, bar);
            __builtin_amdgcn_fence(__ATOMIC_ACQUIRE, "agent");
            xb_add(&bar[XB_XGEN(b.x)], 1u);
            asm volatile("s_waitcnt vmcnt(0)" ::: "memory");
        } else {
            XB_SPIN(xb_ld(&bar[XB_XGEN(b.x)]) == gen, bar);
            __builtin_amdgcn_fence(__ATOMIC_ACQUIRE, "agent");
            asm volatile("s_waitcnt vmcnt(0)" ::: "memory");
        }
    }
    __syncthreads();
}

__global__ void __launch_bounds__(NTHREADS, 2) fwd_kernel(Params p) {
    extern __shared__ __attribute__((aligned(16))) unsigned char lds[];
    cg::grid_group grid = cg::this_grid();
    volatile LAS unsigned* bst = (volatile LAS unsigned*)((LAS unsigned char*)lds + LDS_LUT + 7168);
    if (threadIdx.x == 0) { bst[0] = 0u; bst[1] = 0u; }
    __syncthreads();
    XcdBarrier xbar = xcd_barrier_post((unsigned*)(p.ws + WS_CTL), bst);
    unsigned char* ws = p.ws;
    bf16* XB = (bf16*)(ws + WS_XB); bf16* PB = (bf16*)(ws + WS_PB); float* Y = (float*)(ws + WS_Y);
    for (int ph = p.ph_lo; ph < p.ph_hi; ++ph) {
        if (ph > p.ph_lo) { if (ph == 1) grid.sync(); else xcd_barrier(xbar); for (int e_ = 0; e_ < DUP_SYNC; ++e_) xcd_barrier(xbar); }
        if (ph == 0) { for (int e_ = 0; e_ < DUP_PRO; ++e_) prologue_phase(p, lds); continue; }
        int l, s;
        if (ph < 13) { l = 0; s = ph - 1; } else if (ph < 23) { l = 1; s = ph - 13; } else if (ph < 35) { l = 2; s = ph - 23; } else { l = 3; s = ph - 35; }
        if (l & 1) s = (s < 4) ? s : (s == 4) ? 5 : s + 2;
        const int j = l >> 1;
        const float* base = (ph <= 2) ? p.in[0] : p.out;
        for (int rep_ = 0; rep_ < (((DUP_PH >> s) & 1) ? 2 : 1); ++rep_)
        if (s == 0 || s == 9) {
            const int f = (s == 9);
            pg8::Gemm g{XB, (const bf16*)(ws + WS_WFI + (size_t)(l * 2 + f) * SZ_WFI), MTOK, 5632, 1024}; pg8::StaticOrder S; S.init(MTOK, 5632, gridDim.x, blockIdx.x);
            pg8::EpiAct E{PB, DFF, 0};
            if (EN_GEMM1) pg8::gemm_phase<pg8::EpiAct, pg8::StaticOrder, true, true>((PG8_LAS unsigned char*)lds, g, S, E);
        } else if (s == 3 && (l & 1)) {
            pg8::Gemm g{XB, (const bf16*)(ws + WS_WCI + (size_t)j * SZ_WCI), MTOK, 2048, 1024}; pg8::StaticOrder S; S.init(MTOK, 2048, gridDim.x, blockIdx.x);
            pg8::EpiAct E{PB, DM, 1};
            if (EN_GEMM1) pg8::gemm_phase<pg8::EpiAct, pg8::StaticOrder, true, true>((PG8_LAS unsigned char*)lds, g, S, E);
        } else if (s == 1 || s == 10) {
            const int f = (s == 10);
            pg8::Gemm g{PB, (const bf16*)(ws + WS_WFO + (size_t)(l * 2 + f) * SZ_WFO), MTOK, DM, DFF}; pg8::StaticOrder S; S.init(MTOK, DM, gridDim.x, blockIdx.x);
            pg8::EpiRes E{base, Y, DM, ALPHA, 0.5f};
            if (EN_GEMM2) pg8::gemm_phase<pg8::EpiRes, pg8::StaticOrder, true, true>((PG8_LAS unsigned char*)lds, g, S, E);
        } else if (s == 7) {
            const bf16* Wt = (l & 1) ? (const bf16*)(ws + WS_WCO + (size_t)j * SZ_WCO) : (const bf16*)(ws + WS_WMO + (size_t)j * SZ_WMO);
            pg8::Gemm g{XB, Wt, MTOK, DM, DM}; pg8::StaticOrder S; S.init(MTOK, DM, gridDim.x, blockIdx.x);
            pg8::EpiRes E{base, Y, DM, ALPHA, 1.0f};
            if (EN_GEMM2) pg8::gemm_phase<pg8::EpiRes, pg8::StaticOrder, true, true>((PG8_LAS unsigned char*)lds, g, S, E);
        } else if (s == 3) {
            pg8::Gemm g{XB, (const bf16*)(ws + WS_WMI + (size_t)j * SZ_WMI), MTOK, PW, 1024}; pg8::StaticOrder S; S.init(MTOK, PW, gridDim.x, blockIdx.x);
            pg8::EpiBf16 E{PB, PW};
            if (EN_GEMM3) pg8::gemm_phase<pg8::EpiBf16, pg8::StaticOrder, true, true>((PG8_LAS unsigned char*)lds, g, S, E);
        } else if (s == 2 || s == 8 || s == 11) {
            const int which = (s == 2) ? 0 : (s == 8) ? 1 : 2;
            if (EN_LN) ln_phase(Y, p.in[3] + (size_t)(l * 3 + which) * DM, p.in[4] + (size_t)(l * 3 + which) * DM, p.out, XB);
        } else if (s == 4) {
            if (EN_IKLN) ikln_phase(PB, p.in[7] + (size_t)j * 64, p.in[8] + (size_t)j * 64, (bf16*)(ws + WS_IK));
        } else if (s == 5 && !(l & 1)) {
            att_phase(p, lds, l);
        } else if (s == 6) {
            attb_phase(p, lds);
        } else if (s == 5) {
            for (int e_ = 0; e_ < DUP_CONV; ++e_) conv_phase(lds, PB, p.in[13] + (size_t)j * 31 * DM, p.in[14] + (size_t)j * DM, p.in[15] + (size_t)j * DM, p.in[16] + (size_t)j * DM, XB);
        }
    }
}
constexpr int NPHASES = 45;

#ifndef ONE_LAUNCH
#define ONE_LAUNCH 1
#endif
extern "C" void kernel_launch(void* const* d_in, const int* in_sizes, int n_in, void* d_out, int out_size, void* d_ws, size_t ws_size, hipStream_t stream) {
    static int grid = 0;
    if (grid == 0) {
        if (n_in != 18 || in_sizes[0] != MTOK * DM || out_size != MTOK * DM || ws_size < WS_END) { fprintf(stderr, "kernel_launch: unexpected shapes (n_in %d, in0 %d, out %d, ws %zu)\n", n_in, n_in > 0 ? in_sizes[0] : -1, out_size, ws_size); grid = -1; return; }
        int dev = 0, cus = 0, per_cu = 0;
        if (hipGetDevice(&dev) != hipSuccess || hipDeviceGetAttribute(&cus, hipDeviceAttributeMultiprocessorCount, dev) != hipSuccess) { grid = -1; return; }
        if (hipFuncSetAttribute((const void*)fwd_kernel, hipFuncAttributeMaxDynamicSharedMemorySize, LDS_BYTES) != hipSuccess) { fprintf(stderr, "kernel_launch: hipFuncSetAttribute failed\n"); grid = -1; return; }
        if (hipOccupancyMaxActiveBlocksPerMultiprocessor(&per_cu, (const void*)fwd_kernel, NTHREADS, LDS_BYTES) != hipSuccess || per_cu < 1) { fprintf(stderr, "kernel_launch: occupancy query gave %d\n", per_cu); per_cu = 1; }
        (void)hipGetLastError();
        grid = cus;
    }
    if (grid < 0) return;
    Params p{};
    for (int i = 0; i < 18; ++i) p.in[i] = (const float*)d_in[i];
    p.out = (float*)d_out; p.ws = (unsigned char*)d_ws;
    if (hipMemsetAsync((char*)d_ws + WS_CTL, 0, CTL_BYTES, stream) != hipSuccess) { fprintf(stderr, "kernel_launch: memset failed\n"); return; }
#if ONE_LAUNCH
    p.ph_lo = 0; p.ph_hi = NPHASES;
    void* args[] = {&p};
    hipError_t e = hipLaunchCooperativeKernel((const void*)fwd_kernel, dim3(grid), dim3(NTHREADS), args, LDS_BYTES, stream);
    if (e != hipSuccess) fprintf(stderr, "cooperative launch failed: %s (grid %d)\n", hipGetErrorString(e), grid);
#else
    for (int ph = 0; ph < NPHASES; ++ph) { p.ph_lo = ph; p.ph_hi = ph + 1; hipLaunchKernelGGL(fwd_kernel, dim3(grid), dim3(NTHREADS), LDS_BYTES, stream, p); }
#endif
}
```
